# Optimizing an MI355X kernel written in HIP

```python
import math
import jax, jax.numpy as jnp
from jax import lax
import numpy as np

D_MODEL = 1024
BATCH = 8
SEQ = 8192
DEPTH = 2
DEC_BATCH = 16
DEC_SEQ = 16
PAST_LEN = 1024

CHUNK = 64
N_A_LAYERS = DEPTH // 2
N_B_LAYERS = DEPTH - N_A_LAYERS
HG_EXPAND = 128
HG_HEADS = D_MODEL // HG_EXPAND
HG_K = HG_EXPAND
HG_V = D_MODEL // HG_HEADS
DA_HEADS = 8
DA_HEAD_DIM = D_MODEL // (2 * DA_HEADS)
DA_V_DIM = 2 * DA_HEAD_DIM
D_FF = 4 * D_MODEL
Q_BLOCK = 128
NORM_EPS = 1e-6
LAMBDA_STD = 0.1

kernel_name = 'yoco_hgrn2_diffattn_stream_step'


def _rmsnorm(x, g):
    x32 = x.astype(jnp.float32)
    y = x32 * lax.rsqrt(jnp.mean(jnp.square(x32), axis=-1, keepdims=True) + NORM_EPS)
    return (y * g.astype(jnp.float32)).astype(x.dtype)


def _sqrelu_mlp(x, w_up, w_down):
    return jnp.square(jax.nn.relu(x @ w_up)) @ w_down


def _gla_chunk_step(S, xs):
    q, k, v, g = xs
    C = q.shape[1]
    b = jnp.cumsum(g, axis=1)
    causal = jnp.tril(jnp.ones((C, C), dtype=bool))
    diff = b[:, :, None] - b[:, None, :]
    decay = jnp.exp(jnp.where(causal[None, :, :, None, None], diff, -jnp.inf))
    a = jnp.einsum('bthk,bshk,btshk->bhts', q, k, decay)
    o = jnp.einsum('bhts,bshv->bthv', a, v) + jnp.einsum('bthk,bhkv->bthv', q * jnp.exp(b), S)
    b_last = b[:, -1]
    S_new = jnp.exp(b_last)[..., None] * S + jnp.einsum(
        'bshk,bshv->bhkv', k * jnp.exp(b_last[:, None] - b), v)
    return S_new, o


def _hgrn2(a, s0, w_in, lb, onorm_g, w_o, is_prompt):
    B, T, _ = a.shape
    q, f, i, g = jnp.split(a @ w_in, 4, axis=-1)
    fg = lb + (1.0 - lb) * jax.nn.sigmoid(f.astype(jnp.float32))
    shp = (B, T, HG_HEADS, HG_K)
    qh = jax.nn.silu(q.astype(jnp.float32)).reshape(shp)
    kh = (1.0 - fg).reshape(shp)
    gh = jnp.log(fg).reshape(shp)
    vh = i.astype(jnp.float32).reshape(B, T, HG_HEADS, HG_V)
    S0 = s0.astype(jnp.float32)
    if is_prompt:
        nc = T // CHUNK
        def to_chunks(z):
            return z.reshape((B, nc, CHUNK) + z.shape[2:]).swapaxes(0, 1)
        S_new, o = lax.scan(_gla_chunk_step, S0, (to_chunks(qh), to_chunks(kh), to_chunks(vh), to_chunks(gh)))
        o = o.swapaxes(0, 1).reshape(B, T, HG_HEADS, HG_V)
    else:
        S_new, o = _gla_chunk_step(S0, (qh, kh, vh, gh))
    gate = jax.nn.silu(g.astype(jnp.float32)).reshape(B, T, HG_HEADS, HG_V)
    o = _rmsnorm(o, onorm_g.reshape(HG_HEADS, HG_V)) * gate
    return o.reshape(B, T, D_MODEL).astype(a.dtype) @ w_o, S_new


def _chunk_mask(qpos, kpos):
    return (kpos[None, :] // CHUNK) <= (qpos[:, None] // CHUNK)


def _diff_core(q, k, v, mask, lam):
    s = jnp.einsum('bqhcd,bkhcd->bhcqk', q, k).astype(jnp.float32) * (DA_HEAD_DIM ** -0.5)
    s = jnp.where(mask, s, -jnp.inf)
    p = jax.nn.softmax(s, axis=-1)
    w = p[:, :, 0] - lam * p[:, :, 1]
    return jnp.einsum('bhqk,bkhe->bqhe', w.astype(v.dtype), v)


def _diff_attn(a, k_new, v_new, past_k, past_v, w_q, lam_p, subln_g, w_o, layer_idx):
    B, T, _ = a.shape
    q = (a @ w_q).reshape(B, T, DA_HEADS, 2, DA_HEAD_DIM)
    lam_init = 0.8 - 0.6 * math.exp(-0.3 * layer_idx)
    lp = lam_p.astype(jnp.float32)
    lam = jnp.exp(jnp.sum(lp[0] * lp[1])) - jnp.exp(jnp.sum(lp[2] * lp[3])) + lam_init
    if past_k is None:
        nb = T // Q_BLOCK
        qb = q.reshape(B, nb, Q_BLOCK, DA_HEADS, 2, DA_HEAD_DIM).swapaxes(0, 1)
        kpos = jnp.arange(T)
        def blk(args):
            qi, start = args
            qpos = start + jnp.arange(Q_BLOCK)
            return _diff_core(qi, k_new, v_new, _chunk_mask(qpos, kpos), lam)
        o = lax.map(blk, (qb, jnp.arange(nb) * Q_BLOCK))
        o = o.swapaxes(0, 1).reshape(B, T, DA_HEADS, DA_V_DIM)
    else:
        P = past_k.shape[1]
        k = jnp.concatenate([past_k.astype(k_new.dtype), k_new], axis=1)
        v = jnp.concatenate([past_v.astype(v_new.dtype), v_new], axis=1)
        mask = _chunk_mask(P + jnp.arange(T), jnp.arange(P + T))
        o = _diff_core(q, k, v, mask, lam)
    o = _rmsnorm(o, subln_g) * (1.0 - lam_init)
    return o.reshape(B, T, D_MODEL) @ w_o


def _trunk(x, hg_state0, past_k, past_v, norm_g, w_hgrn_in, hgrn_lb_logits, hgrn_onorm_g,
           w_hgrn_out, kv_norm_g, w_kv, w_dq, diff_lambda, diff_subln_g, w_do, w_up, w_down):
    is_prompt = past_k is None
    B, T, _ = x.shape
    lb_all = jnp.cumsum(jax.nn.softmax(hgrn_lb_logits.astype(jnp.float32), axis=0), axis=0)
    h = x
    new_states = []
    k_new = None
    v_new = None
    for l in range(DEPTH):
        a = _rmsnorm(h, norm_g[l, 0])
        if l < N_A_LAYERS:
            m, s_new = _hgrn2(a, hg_state0[l], w_hgrn_in[l], lb_all[l], hgrn_onorm_g[l],
                              w_hgrn_out[l], is_prompt)
            new_states.append(s_new.astype(hg_state0.dtype))
        else:
            j = l - N_A_LAYERS
            if j == 0:
                kv = _rmsnorm(h, kv_norm_g) @ w_kv
                k_new = kv[..., :D_MODEL].reshape(B, T, DA_HEADS, 2, DA_HEAD_DIM)
                v_new = kv[..., D_MODEL:].reshape(B, T, DA_HEADS, DA_V_DIM)
            m = _diff_attn(a, k_new, v_new, past_k, past_v, w_dq[j], diff_lambda[j],
                           diff_subln_g[j], w_do[j], l)
        h = h + _rmsnorm(m, norm_g[l, 1])
        f = _sqrelu_mlp(_rmsnorm(h, norm_g[l, 2]), w_up[l], w_down[l])
        h = h + _rmsnorm(f, norm_g[l, 3])
    return h, k_new, v_new, jnp.stack(new_states)


def setup_inputs(seed: int = 0) -> dict:
    key = jax.random.key(seed)
    ks = jax.random.split(key, 20)
    f32 = jnp.float32
    def w(k, shape, fan_in):
        return jax.random.normal(k, shape, f32) * (fan_in ** -0.5)
    def gain(k, shape):
        return 1.0 + 0.01 * jax.random.normal(k, shape, f32)
    return {
        'x_prompt': jax.random.normal(ks[0], (BATCH, SEQ, D_MODEL), f32),
        'x_sample': jax.random.normal(ks[1], (DEC_BATCH, DEC_SEQ, D_MODEL), f32),
        'cache_k': jax.random.normal(ks[2], (DEC_BATCH, PAST_LEN, DA_HEADS, 2, DA_HEAD_DIM), f32),
        'cache_v': jax.random.normal(ks[3], (DEC_BATCH, PAST_LEN, DA_HEADS, DA_V_DIM), f32),
        'state_hgrn': 0.5 * jax.random.normal(ks[4], (N_A_LAYERS, DEC_BATCH, HG_HEADS, HG_K, HG_V), f32),
        'norm_g': gain(ks[5], (DEPTH, 4, D_MODEL)),
        'w_hgrn_in': w(ks[6], (N_A_LAYERS, D_MODEL, 4 * D_MODEL), D_MODEL),
        'hgrn_lb_logits': 0.1 * jax.random.normal(ks[7], (N_A_LAYERS + 1, D_MODEL), f32),
        'hgrn_onorm_g': gain(ks[8], (N_A_LAYERS, D_MODEL)),
        'w_hgrn_out': w(ks[9], (N_A_LAYERS, D_MODEL, D_MODEL), D_MODEL),
        'kv_norm_g': gain(ks[10], (D_MODEL,)),
        'w_kv': w(ks[11], (D_MODEL, 2 * D_MODEL), D_MODEL),
        'w_dq': w(ks[12], (N_B_LAYERS, D_MODEL, D_MODEL), D_MODEL),
        'diff_lambda': LAMBDA_STD * jax.random.normal(ks[13], (N_B_LAYERS, 4, DA_HEAD_DIM), f32),
        'diff_subln_g': gain(ks[14], (N_B_LAYERS, DA_V_DIM)),
        'w_do': w(ks[15], (N_B_LAYERS, D_MODEL, D_MODEL), D_MODEL),
        'w_up': w(ks[16], (DEPTH, D_MODEL, D_FF), D_MODEL),
        'w_down': w(ks[17], (DEPTH, D_FF, D_MODEL), D_FF),
    }


def reference(x_prompt, x_sample, cache_k, cache_v, state_hgrn, norm_g, w_hgrn_in, hgrn_lb_logits,
              hgrn_onorm_g, w_hgrn_out, kv_norm_g, w_kv, w_dq, diff_lambda, diff_subln_g, w_do,
              w_up, w_down):
    s0 = jnp.zeros((N_A_LAYERS, x_prompt.shape[0], HG_HEADS, HG_K, HG_V), x_prompt.dtype)
    y_prompt, k_prompt, v_prompt, st_prompt = _trunk(
        x_prompt, s0, None, None, norm_g, w_hgrn_in, hgrn_lb_logits, hgrn_onorm_g, w_hgrn_out,
        kv_norm_g, w_kv, w_dq, diff_lambda, diff_subln_g, w_do, w_up, w_down)
    y_sample, k_sample, v_sample, st_sample = _trunk(
        x_sample, state_hgrn, cache_k, cache_v, norm_g, w_hgrn_in, hgrn_lb_logits, hgrn_onorm_g,
        w_hgrn_out, kv_norm_g, w_kv, w_dq, diff_lambda, diff_subln_g, w_do, w_up, w_down)
    return (y_prompt, y_sample, k_prompt, v_prompt, st_prompt, k_sample, v_sample, st_sample)
```

```cpp
#include <hip/hip_runtime.h>
#include <cstdio>
#include <cstdint>
namespace pg8 {
#define PG8_LAS __attribute__((address_space(3)))
typedef unsigned short bf16_t;
typedef short bf16x8 __attribute__((ext_vector_type(8)));
typedef float f32x4 __attribute__((ext_vector_type(4)));
typedef unsigned u32x4 __attribute__((ext_vector_type(4)));
constexpr int BM = 256, BK = 64, HALF = 128, HTB = HALF * BK * 2  , STAGE_BYTES = 8 * HTB, NXCD = 8, WGM = 8;

__host__ __device__ __forceinline__ int lds_byte(int r, int c) { const int st = (r >> 4) * 2 + (c >> 5), rr = r & 15, cc = c & 31, ob = rr * 64 + cc * 2; return st * 1024 + (ob ^ (((ob >> 9) & 1) << 5)); }
__host__ __device__ __forceinline__ void stage_rc(int b, int& R, int& C) { const int st = b / 1024, sb = b % 1024, swz = sb ^ (((sb >> 9) & 1) << 5); R = (st >> 1) * 16 + swz / 64; C = (st & 1) * 32 + (swz % 64) / 2; }
__host__ __device__ __forceinline__ int perm32(int rho) { const int n = rho >> 4, i = rho & 15; return 8 * (i >> 2) + 4 * n + (i & 3); }

struct Unit { int pm, pn; };
struct Gemm { const bf16_t* A; const bf16_t* Bt; int M, N, K; };

struct StaticOrder {
    int nM, nN, nwg, G, c, spl, nfull, ntk;
    __host__ __device__ __forceinline__ void init(int M, int N, int G_, int c_, int K = 0, int spl_ = 1) { nM = M / BM; nN = N / BM; G = G_; c = c_; spl = spl_; ntk = K / BK;
        if (spl > 1) { nM -= 1; nfull = nM * nN; nwg = nfull + nN * spl; } else { nfull = nwg = nM * nN; } }
    __host__ __device__ __forceinline__ bool next(int i, Unit& u) const {
        const long L = (long)i * G + c; if (L >= nwg) return false;
        if (L >= nfull) { const int j = (int)(L - nfull); u.pm = nM; u.pn = (j % nN) | ((j / nN + 1) << 8); return true; }
        int wgid = (int)L; { const int q = nfull / NXCD, r = nfull % NXCD, xcd = wgid % NXCD, off = wgid / NXCD; wgid = (xcd < r ? xcd * (q + 1) : r * (q + 1) + (xcd - r) * q) + off; }
        const int nig = WGM * nN, gid = wgid / nig, fm = gid * WGM, gsz = (nM - fm) < WGM ? (nM - fm) : WGM;
        u.pm = fm + ((wgid % nig) % gsz); u.pn = (wgid % nig) / gsz; return true;
    }
    __device__ __forceinline__ void a_ready(const Unit&) const {}
    __device__ __forceinline__ void done(const Unit&) const {}
};
typedef float cvt_f32x2_t __attribute__((ext_vector_type(2))); typedef __bf16 cvt_bf16x2_t __attribute__((ext_vector_type(2)));
__device__ __forceinline__ unsigned cvt_pk_bf16(float lo, float hi) { cvt_f32x2_t v = {lo, hi}; cvt_bf16x2_t b = __builtin_convertvector(v, cvt_bf16x2_t); return __builtin_bit_cast(unsigned, b); }
typedef float f32x2 __attribute__((ext_vector_type(2)));

typedef unsigned u32x4 __attribute__((ext_vector_type(4)));
__device__ __forceinline__ float fast_rcp(float x) { return __builtin_amdgcn_rcpf(x); }
__device__ __forceinline__ float silu_f(float x) { return x * fast_rcp(1.0f + __expf(-x)); }
template <int MODE> struct EpiAct {
    static constexpr bool PERM = true, AFTER_DRAIN = false;
    bf16_t* O; int ldc; const float* aux; float* kvp; float* kvs; size_t split_stride; float scale0; float* pacc = nullptr;
    __device__ __forceinline__ void operator()(const f32x4 (&acc)[2][2][4][2], const Unit& u, int wr, int wc, int fr, int fq) const {
        const int row0 = u.pm * BM + wr * 64 + fr;
        const int upn = u.pn & 255, upart = u.pn >> 8; int colt = upn * BM; bf16_t* base = O; float* fbase = nullptr; int type = 0;
        if (MODE == 2) type = upn >> 2;
        if (MODE == 3) { type = upn >> 2; colt -= type * 1024; base = O + (size_t)type * split_stride;
            if (type > 0) { fbase = (u.pm < 256) ? kvp + (size_t)(type - 1) * (65536u * 1024u) : (kvs + (size_t)(type - 1) * (256u * 1024u)) - (size_t)65536 * 1024; } }
        const int col0 = colt + wc * 32 + 8 * fq;
        f32x4 av[2][2];
        if (MODE == 2) {
#pragma unroll
            for (int bj = 0; bj < 2; ++bj)
#pragma unroll
                for (int n = 0; n < 2; ++n) av[bj][n] = (type == 1) ? *(const f32x4*)(aux + ((col0 + bj * HALF + 4 * n) & 1023)) : (f32x4){0.f, 0.f, 0.f, 0.f};
        }
#pragma unroll
        for (int ai = 0; ai < 2; ++ai)
#pragma unroll
            for (int m = 0; m < 4; ++m) { const size_t roff = (size_t)(row0 + ai * HALF + m * 16) * ldc + col0; bf16_t* rowp = base + roff;
#pragma unroll
                for (int bj = 0; bj < 2; ++bj) { f32x4 v0 = acc[ai][bj][m][0], v1 = acc[ai][bj][m][1];
                    if (MODE == 0 && upart != 0) { float* fp = pacc + (size_t)(upart - 1) * (256u * 1024u) + (size_t)(wr * 64 + fr + ai * HALF + m * 16) * ldc + col0 + bj * HALF; *(f32x4*)fp = v0; *(f32x4*)(fp + 4) = v1; continue; }
                    if (MODE == 1) {
#pragma unroll
                        for (int e = 0; e < 4; ++e) { const float a = fmaxf(v0[e], 0.f), b = fmaxf(v1[e], 0.f); v0[e] = a * a; v1[e] = b * b; } }
                    if (MODE == 2) {
                        if (type == 0 || type == 3) {
#pragma unroll
                            for (int e = 0; e < 4; ++e) { v0[e] = silu_f(v0[e]); v1[e] = silu_f(v1[e]); } }
                        else if (type == 1) {
#pragma unroll
                            for (int e = 0; e < 4; ++e) { v0[e] = av[bj][0][e] * fast_rcp(1.0f + __expf(v0[e])); v1[e] = av[bj][1][e] * fast_rcp(1.0f + __expf(v1[e])); } }
                    }
                    if (MODE == 3) {
                        if (type == 0) { v0 = v0 * scale0; v1 = v1 * scale0; }
                        else { float* fp = fbase + roff + bj * HALF; *(f32x4*)fp = v0; *(f32x4*)(fp + 4) = v1; }
                    }
                    u32x4 w; w.x = cvt_pk_bf16(v0[0], v0[1]); w.y = cvt_pk_bf16(v0[2], v0[3]); w.z = cvt_pk_bf16(v1[0], v1[1]); w.w = cvt_pk_bf16(v1[2], v1[3]);
                    *(u32x4*)(rowp + bj * HALF) = w; } }
    }
};

template <class Epi, class Sched, bool ALIGN_EPI = false, bool SP2 = false>
__device__ __forceinline__ void gemm_phase(PG8_LAS unsigned char* lds, const Gemm g, const Sched& S, const Epi& E) {
    int tid_ = threadIdx.x; asm volatile("" : "+v"(tid_));
    const int tid = tid_, wid = __builtin_amdgcn_readfirstlane(tid >> 6), lane = tid & 63, wr = wid >> 2, wc = wid & 3, fr = lane & 15, fq = lane >> 4;
    const int K = g.K, nt = K / BK;
    unsigned voffA[2], voffB[2];
#pragma unroll
    for (int i = 0; i < 2; ++i) { int R, C; stage_rc(tid * 16 + i * 8192, R, C); const int Rb = Epi::PERM ? ((R & ~31) + perm32(R & 31)) : R;
        voffA[i] = (unsigned)(R * K + C) * 2u; voffB[i] = (unsigned)(Rb * K + C) * 2u; }
    const size_t kstep = (size_t)(BK * 2);
    const size_t hstep = (size_t)HALF * K * 2;
    const size_t tstep = 2 * hstep;
    const unsigned ldsw = (unsigned)wid * 1024u;
    const int aoff = lds_byte(wr * 64 + fr, fq * 8), boff = lds_byte(wc * 32 + fr, fq * 8);
#define PG8_SA(b, h) (((b) * 2 + (h)) * HTB)
#define PG8_SB(b, h) ((4 + (b) * 2 + (h)) * HTB)
#define PG8_STAGE(bufoff, gbase, voff) do { _Pragma("unroll") for (int _i = 0; _i < 2; ++_i) \
        __builtin_amdgcn_global_load_lds((const unsigned*)((const char*)(gbase) + (voff)[_i]), (PG8_LAS unsigned*)(lds + (bufoff) + ldsw + _i * 8192), 16, 0, 0); } while (0)
#define PG8_LDA(dst, b, h) do { _Pragma("unroll") for (int m = 0; m < 4; ++m) _Pragma("unroll") for (int k = 0; k < 2; ++k) dst[m][k] = *(const PG8_LAS bf16x8*)(lds + PG8_SA(b, h) + aoff + m * 2048 + k * 1024); } while (0)
#define PG8_LDB(dst, b, h) do { _Pragma("unroll") for (int n = 0; n < 2; ++n) _Pragma("unroll") for (int k = 0; k < 2; ++k) dst[n][k] = *(const PG8_LAS bf16x8*)(lds + PG8_SB(b, h) + boff + n * 2048 + k * 1024); } while (0)
#define PG8_MMA(ai, bj, At, Bt) do { __builtin_amdgcn_s_setprio(1); _Pragma("unroll") for (int m = 0; m < 4; ++m) _Pragma("unroll") for (int n = 0; n < 2; ++n) _Pragma("unroll") for (int k = 0; k < 2; ++k) \
        acc[ai][bj][m][n] = __builtin_amdgcn_mfma_f32_16x16x32_bf16(Bt[n][k], At[m][k], acc[ai][bj][m][n], 0, 0, 0); __builtin_amdgcn_s_setprio(0); } while (0)
#define PG8_WAIT_V(n) asm volatile("s_waitcnt vmcnt(" #n ")" ::: "memory")
#define PG8_WAIT_L(n) asm volatile("s_waitcnt lgkmcnt(" #n ")" ::: "memory")
#define PG8_BAR __builtin_amdgcn_s_barrier()
#define PG8_SCHED __builtin_amdgcn_sched_barrier(0)
    Unit cur, nxt; int ui = 0;
    if (!S.next(0, cur)) return;
    const int nktp = S.spl > 1 ? S.ntk / S.spl : nt;
#define PG8_NT(u) (((u).pn >> 8) ? nktp : nt)
#define PG8_K0(u) ((size_t)(((u).pn >> 8) ? (((u).pn >> 8) - 1) * nktp : 0) * kstep)
    int ntc = PG8_NT(cur);
    f32x4 acc[2][2][4][2];
#pragma unroll
    for (int a = 0; a < 2; ++a)
#pragma unroll
        for (int b = 0; b < 2; ++b)
#pragma unroll
            for (int m = 0; m < 4; ++m)
#pragma unroll
                for (int n = 0; n < 2; ++n) acc[a][b][m][n] = (f32x4){0.f, 0.f, 0.f, 0.f};
    bf16x8 At[4][2], B0[2][2], B1[2][2];
    const char* cA = (const char*)g.A + (size_t)cur.pm * tstep + PG8_K0(cur); const char* cB = (const char*)g.Bt + (size_t)(cur.pn & 255) * tstep + PG8_K0(cur);
    S.a_ready(cur);
    if constexpr (SP2) {
        PG8_STAGE(PG8_SB(0, 0), cB, voffB); PG8_STAGE(PG8_SB(0, 1), cB + hstep, voffB); PG8_STAGE(PG8_SA(0, 0), cA, voffA); PG8_STAGE(PG8_SA(0, 1), cA + hstep, voffA);
        if (wr == 1) PG8_BAR;
        PG8_WAIT_V(2); PG8_BAR;
        PG8_STAGE(PG8_SB(1, 0), cB + kstep, voffB); PG8_STAGE(PG8_SA(1, 0), cA + kstep, voffA); PG8_STAGE(PG8_SB(1, 1), cB + hstep + kstep, voffB);
        PG8_WAIT_V(6); PG8_BAR;
    } else {
        PG8_STAGE(PG8_SB(0, 0), cB, voffB); PG8_STAGE(PG8_SA(0, 0), cA, voffA); PG8_STAGE(PG8_SB(0, 1), cB + hstep, voffB); PG8_STAGE(PG8_SA(0, 1), cA + hstep, voffA);
        if (wr == 1) PG8_BAR;
        PG8_WAIT_V(4); PG8_BAR;
        PG8_STAGE(PG8_SB(1, 0), cB + kstep, voffB); PG8_STAGE(PG8_SA(1, 0), cA + kstep, voffA); PG8_STAGE(PG8_SB(1, 1), cB + hstep + kstep, voffB);
        PG8_WAIT_V(6); PG8_BAR;
    }
    for (;;) {
        const bool has_next = S.next(ui + 1, nxt);
        const char* nA = has_next ? (const char*)g.A + (size_t)nxt.pm * tstep + PG8_K0(nxt) : cA; const char* nB = has_next ? (const char*)g.Bt + (size_t)(nxt.pn & 255) * tstep + PG8_K0(nxt) : cB;
        for (int t = 0; t < ntc; t += 2) {
            const bool last = (t == ntc - 2);
            const char* a1 = cA + (size_t)(t + 1) * kstep;
            const char* a2 = last ? nA : cA + (size_t)(t + 2) * kstep; const char* b2 = last ? nB : cB + (size_t)(t + 2) * kstep;
            const char* a3 = a2 + kstep; const char* b3 = b2 + kstep;
            if (last && has_next) S.a_ready(nxt);
            if constexpr (SP2) {
            PG8_LDB(B0, 0, 0); PG8_LDB(B1, 0, 1); PG8_SCHED; PG8_LDA(At, 0, 0); PG8_STAGE(PG8_SA(1, 1), a1 + hstep, voffA);
            PG8_WAIT_V(8); PG8_WAIT_L(0); PG8_BAR; PG8_MMA(0, 0, At, B0); PG8_MMA(0, 1, At, B1); PG8_BAR; PG8_SCHED;
            PG8_LDA(At, 0, 1); PG8_STAGE(PG8_SB(0, 0), b2, voffB); PG8_STAGE(PG8_SB(0, 1), b2 + hstep, voffB); PG8_STAGE(PG8_SA(0, 0), a2, voffA);
            PG8_WAIT_V(8); PG8_WAIT_L(0); PG8_BAR; PG8_MMA(1, 0, At, B0); PG8_MMA(1, 1, At, B1); PG8_BAR; PG8_SCHED;
            PG8_LDB(B0, 1, 0); PG8_LDB(B1, 1, 1); PG8_SCHED; PG8_LDA(At, 1, 0); PG8_STAGE(PG8_SA(0, 1), a2 + hstep, voffA);
            PG8_WAIT_V(8); PG8_WAIT_L(0); PG8_BAR; PG8_MMA(0, 0, At, B0); PG8_MMA(0, 1, At, B1); PG8_BAR; PG8_SCHED;
            PG8_LDA(At, 1, 1); PG8_STAGE(PG8_SB(1, 0), b3, voffB); PG8_STAGE(PG8_SB(1, 1), b3 + hstep, voffB); PG8_STAGE(PG8_SA(1, 0), a3, voffA);
            PG8_WAIT_V(8); PG8_WAIT_L(0); PG8_BAR; PG8_MMA(1, 0, At, B0); PG8_MMA(1, 1, At, B1); PG8_BAR; PG8_SCHED;
            } else {
            PG8_LDB(B0, 0, 0); PG8_SCHED; PG8_LDA(At, 0, 0); PG8_STAGE(PG8_SA(1, 1), a1 + hstep, voffA);
            PG8_WAIT_L(8); PG8_BAR; PG8_WAIT_L(0); PG8_MMA(0, 0, At, B0); PG8_BAR; PG8_SCHED;
            PG8_LDB(B1, 0, 1); PG8_STAGE(PG8_SB(0, 0), b2, voffB);
            PG8_BAR; PG8_WAIT_L(0); PG8_MMA(0, 1, At, B1); PG8_BAR;
            PG8_LDA(At, 0, 1); PG8_STAGE(PG8_SA(0, 0), a2, voffA);
            PG8_BAR; PG8_WAIT_L(0); PG8_MMA(1, 0, At, B0); PG8_BAR; PG8_SCHED;
            PG8_STAGE(PG8_SB(0, 1), b2 + hstep, voffB);
            PG8_WAIT_V(6); PG8_BAR; PG8_MMA(1, 1, At, B1); PG8_BAR;
            PG8_LDB(B0, 1, 0); PG8_SCHED; PG8_LDA(At, 1, 0); PG8_STAGE(PG8_SA(0, 1), a2 + hstep, voffA);
            PG8_WAIT_L(8); PG8_BAR; PG8_WAIT_L(0); PG8_MMA(0, 0, At, B0); PG8_BAR; PG8_SCHED;
            PG8_LDB(B1, 1, 1); PG8_STAGE(PG8_SB(1, 0), b3, voffB);
            PG8_BAR; PG8_WAIT_L(0); PG8_MMA(0, 1, At, B1); PG8_BAR;
            PG8_LDA(At, 1, 1); PG8_STAGE(PG8_SA(1, 0), a3, voffA);
            PG8_BAR; PG8_WAIT_L(0); PG8_MMA(1, 0, At, B0); PG8_BAR; PG8_SCHED;
            PG8_STAGE(PG8_SB(1, 1), b3 + hstep, voffB);
            PG8_WAIT_V(6); PG8_BAR; PG8_MMA(1, 1, At, B1); PG8_BAR;
            }
        }
        if constexpr (ALIGN_EPI) { if (wr == 0) PG8_BAR; }
        if constexpr (!Epi::AFTER_DRAIN) { E(acc, cur, wr, wc, fr, fq); S.done(cur); }
        if (!has_next) break;
#pragma unroll
        for (int a = 0; a < 2; ++a)
#pragma unroll
            for (int b = 0; b < 2; ++b)
#pragma unroll
                for (int m = 0; m < 4; ++m)
#pragma unroll
                    for (int n = 0; n < 2; ++n) acc[a][b][m][n] = (f32x4){0.f, 0.f, 0.f, 0.f};
        cur = nxt; cA = nA; cB = nB; ++ui; ntc = PG8_NT(cur);
        if constexpr (ALIGN_EPI) { if (wr == 1) PG8_BAR; }
    }
    PG8_WAIT_V(0);
    if constexpr (!ALIGN_EPI) { if (wr == 0) PG8_BAR; }
    PG8_BAR;
    if constexpr (Epi::AFTER_DRAIN) { E.fused(acc, cur, wr, wc, fr, fq, lds, wid, lane); S.done(cur); }
#undef PG8_SA
#undef PG8_SB
#undef PG8_STAGE
#undef PG8_LDA
#undef PG8_LDB
#undef PG8_MMA
#undef PG8_WAIT_V
#undef PG8_WAIT_L
#undef PG8_BAR
#undef PG8_SCHED
#undef PG8_NT
#undef PG8_K0
}
}
#define PG8_SP2 true
#define PG8_ALIGN true
#include <hip/hip_bf16.h>
#include <cmath>
namespace attn_body {
using bf16=__hip_bfloat16;
using bf16x8=__attribute__((ext_vector_type(8)))short;
using s16x4=__attribute__((ext_vector_type(4)))short;
using f32x16=__attribute__((ext_vector_type(16)))float;
using u32x4=__attribute__((ext_vector_type(4)))unsigned;
constexpr int BATCH=8,NHEAD=16,SEQ=8192,D=64,DM=NHEAD*D;
constexpr int NW=8,QBLK=32,QB=QBLK*NW,KVBLK=64,NQB=SEQ/QB;
constexpr int ATTN_PITCH=DM, ATTN_UNIT_ROWS=QB;
__device__ __forceinline__ int crow(int r,int hi){return (r&3)+8*(r>>2)+4*hi;}
#define SBAR() __builtin_amdgcn_sched_barrier(0)
__device__ __forceinline__ void cmask(f32x16&p0,f32x16&p1,int jb,int qrel,int hi){
  const float NEG=-INFINITY; (void)hi;
  if(jb>(qrel>>6)){
  #pragma unroll
  for(int r=0;r<16;++r){p0[r]=NEG;p1[r]=NEG;} }
}

constexpr int NSLOT=3, SLOTB=8192;
constexpr int LDS_K=0, LDS_V=NSLOT*SLOTB, LDS_WS=2*NSLOT*SLOTB, LDS_OST=LDS_WS+NW*64*4, LDS_BYTES=LDS_OST+NW*4096;
constexpr float C2=0.125f*1.4426950408889634f;
__device__ __forceinline__ void glds16(const void*gsrc,unsigned lds_dst){unsigned keep;
  asm volatile("s_mov_b32 %0, m0\n\ts_mov_b32 m0, %2\n\ts_nop 0\n\tglobal_load_lds_dwordx4 %1, off\n\ts_mov_b32 m0, %0":"=&s"(keep):"v"(gsrc),"s"(lds_dst):"memory");}
__device__ __forceinline__ float max3f(float a,float b,float c){float r;asm("v_max3_f32 %0, %1, %2, %3":"=v"(r):"v"(a),"v"(b),"v"(c));return r;}
__device__ __forceinline__ float max2f(float a,float b){float r;asm("v_max_f32_e32 %0, %1, %2":"=v"(r):"v"(a),"v"(b));return r;}
__device__ __forceinline__ float fadd_s(float a,float b){float r;asm("v_add_f32_e32 %0, %1, %2":"=v"(r):"v"(a),"v"(b));return r;}
__device__ __forceinline__ float fsub_s(float a,float b){float r;asm("v_sub_f32_e32 %0, %1, %2":"=v"(r):"v"(a),"v"(b));return r;}
typedef float f32x2_t __attribute__((ext_vector_type(2))); typedef __bf16 bf16x2_t __attribute__((ext_vector_type(2)));
__device__ __forceinline__ unsigned cvtpk_s(float lo,float hi){f32x2_t v={lo,hi};bf16x2_t b=__builtin_convertvector(v,bf16x2_t);return __builtin_bit_cast(unsigned,b);}
#define WAIT_BAR(N) asm volatile("s_waitcnt vmcnt(" #N ") lgkmcnt(0)\n\ts_barrier":::"memory")

__device__ __forceinline__ void qkt(f32x16&p0,f32x16&p1,const char*Kslot,const bf16x8*qr,const f32x16&negm,int r32,int hi){
  const char*kb=Kslot+hi*1024+r32*16;
  #pragma unroll
  for(int d0=0;d0<4;++d0){
    const bf16x8 b0=*reinterpret_cast<const bf16x8*>(kb+d0*2048);
    const bf16x8 b1=*reinterpret_cast<const bf16x8*>(kb+d0*2048+512);
    if(d0==0){p0=__builtin_amdgcn_mfma_f32_32x32x16_bf16(b0,qr[0],negm,0,0,0);p1=__builtin_amdgcn_mfma_f32_32x32x16_bf16(b1,qr[0],negm,0,0,0);}
    else{p0=__builtin_amdgcn_mfma_f32_32x32x16_bf16(b0,qr[d0],p0,0,0,0);p1=__builtin_amdgcn_mfma_f32_32x32x16_bf16(b1,qr[d0],p1,0,0,0);}}
}
typedef __attribute__((address_space(3))) const char* lds_cptr;
typedef short v4i16_t __attribute__((ext_vector_type(4)));
__device__ __forceinline__ void kload8(bf16x8*kf,lds_cptr kp){
  kf[0]=*(const __attribute__((address_space(3))) bf16x8*)(kp);      kf[1]=*(const __attribute__((address_space(3))) bf16x8*)(kp+512);
  kf[2]=*(const __attribute__((address_space(3))) bf16x8*)(kp+2048); kf[3]=*(const __attribute__((address_space(3))) bf16x8*)(kp+2560);
  kf[4]=*(const __attribute__((address_space(3))) bf16x8*)(kp+4096); kf[5]=*(const __attribute__((address_space(3))) bf16x8*)(kp+4608);
  kf[6]=*(const __attribute__((address_space(3))) bf16x8*)(kp+6144); kf[7]=*(const __attribute__((address_space(3))) bf16x8*)(kp+6656);
}
__device__ __forceinline__ void kload2(bf16x8*kf,lds_cptr kp,int j){ kf[2*j]=*(const __attribute__((address_space(3))) bf16x8*)(kp+j*2048); kf[2*j+1]=*(const __attribute__((address_space(3))) bf16x8*)(kp+j*2048+512); }
__device__ __forceinline__ s16x4 vtr(lds_cptr p){ return __builtin_bit_cast(s16x4,__builtin_amdgcn_ds_read_tr16_b64_v4i16((__attribute__((address_space(3))) v4i16_t*)p)); }
__device__ __forceinline__ float rowmax(const f32x16&p0,const f32x16&p1){
  float a=max3f(p0[0],p0[1],p1[0]),b=max3f(p0[2],p0[3],p1[1]);a=max3f(a,p1[2],p1[3]);
  #pragma unroll
  for(int r=4;r<16;r+=4){a=max3f(a,p0[r],p0[r+1]);b=max3f(b,p0[r+2],p0[r+3]);a=max3f(a,p1[r],p1[r+1]);b=max3f(b,p1[r+2],p1[r+3]);}
  const float m=max2f(a,b);
  auto rr=__builtin_amdgcn_permlane32_swap(__float_as_uint(m),__float_as_uint(m),false,false);
  return max2f(__uint_as_float(rr[0]),__uint_as_float(rr[1]));
}
__device__ __forceinline__ void pv(f32x16*o,int vb,bf16x8 pa0,bf16x8 pa1,bf16x8 pa2,bf16x8 pa3){
  #pragma unroll
  for(int d0=0;d0<2;++d0){s16x4 lo[4],hi[4];
    #pragma unroll
    for(int ks=0;ks<4;++ks){
      asm volatile("ds_read_b64_tr_b16 %0,%1 offset:%c2":"=&v"(lo[ks]):"v"(vb),"i"(d0*4096+ks*1024):"memory");
      asm volatile("ds_read_b64_tr_b16 %0,%1 offset:%c2":"=&v"(hi[ks]):"v"(vb),"i"(d0*4096+ks*1024+512):"memory");}
    asm volatile("s_waitcnt lgkmcnt(0)":::"memory");SBAR();
    #define PK(k) (bf16x8){lo[k][0],lo[k][1],lo[k][2],lo[k][3],hi[k][0],hi[k][1],hi[k][2],hi[k][3]}
    o[d0]=__builtin_amdgcn_mfma_f32_32x32x16_bf16(pa0,PK(0),o[d0],0,0,0);
    o[d0]=__builtin_amdgcn_mfma_f32_32x32x16_bf16(pa1,PK(1),o[d0],0,0,0);
    o[d0]=__builtin_amdgcn_mfma_f32_32x32x16_bf16(pa2,PK(2),o[d0],0,0,0);
    o[d0]=__builtin_amdgcn_mfma_f32_32x32x16_bf16(pa3,PK(3),o[d0],0,0,0);
    #undef PK
  }
}

#ifndef ATTN_STORE16
#define ATTN_STORE16(p,v) (*(u32x4*)(p)=(v))
#endif
template<int THRL> __device__ __forceinline__ void attn_unit(int b,int h,int hv,int qb,const bf16*Q,const bf16*__restrict__ K,const bf16*__restrict__ V,bf16*O,char*shm){
  int tid_=threadIdx.x; asm volatile("":"+v"(tid_)); const int tid=tid_,lane=tid&63,r32=lane&31,hi=lane>>5; const int wid=__builtin_amdgcn_readfirstlane(tid>>6);
  const long rowbase=(long)b*SEQ; const int q0=qb*QB;
  const bf16*Qw=Q+(rowbase+q0+wid*QBLK)*DM+h*D;
  const bf16*Kh=K+rowbase*DM+h*D,*Vh=V+rowbase*DM+hv*D;
  const unsigned lds0=(unsigned)(uintptr_t)shm;
  float*wsf=(float*)(shm+LDS_WS)+wid*64;
  const bf16*ksrc=Kh+(long)lane*DM+wid*8;
  const bf16*vsrc=Vh+(long)(16*(wid&3)+(lane>>2))*DM+(wid>>2)*32+(lane&3)*8;
  const unsigned kdst=lds0+LDS_K+wid*1024, vdst=lds0+LDS_V+wid*1024;
  #define DMA_K(t,slot) glds16(ksrc+(long)(t)*KVBLK*DM,(unsigned)__builtin_amdgcn_readfirstlane(kdst+(slot)))
  #define DMA_V(t,slot) glds16(vsrc+(long)(t)*KVBLK*DM,(unsigned)__builtin_amdgcn_readfirstlane(vdst+(slot)))
  const int vb0=(int)(lds0+LDS_V)+((lane>>4)&1)*32+(lane&3)*8+(4*hi+((lane&15)>>2))*64;
  const char*Kbase=shm+LDS_K; bf16x8 kf[8];
  const lds_cptr shm3=(lds_cptr)shm; const lds_cptr kp0=shm3+LDS_K+hi*1024+r32*16; const lds_cptr vp0=shm3+LDS_V+((lane>>4)&1)*32+(lane&3)*8+(4*hi+((lane&15)>>2))*64;
  const int NT=(q0+QB)/KVBLK;
  DMA_K(0,0);DMA_V(0,0);DMA_K(1,SLOTB);
  bf16x8 qr[4];
  #pragma unroll
  for(int d0=0;d0<4;++d0)qr[d0]=*reinterpret_cast<const bf16x8*>(&Qw[(long)r32*DM+d0*16+hi*8]);
  float mhat=0.f,l_reg=0.f;f32x16 o[2];o[0]=f32x16{};o[1]=f32x16{};f32x16 negm=f32x16{};asm volatile("":"+v"(negm));
  const int qrel=wid*QBLK+r32;
  #define CMASK(P0,P1,t) do{int jb_=(t)-(NT-4); if(jb_>=0)cmask(P0,P1,jb_,qrel,hi);}while(0)
  bool resc=false;
  #define START(P0,P1) do{ const float rm=rowmax(P0,P1); resc=false; \
    { const float dl=rm; mhat=fadd_s(mhat,dl); \
      _Pragma("unroll") for(int r=0;r<16;++r){P0[r]=fsub_s(P0[r],dl);P1[r]=fsub_s(P1[r],dl);} \
      _Pragma("unroll") for(int r=0;r<16;++r)negm[r]=-mhat; asm volatile("":"+v"(negm)); } \
    _Pragma("unroll") for(int r=0;r<16;++r)P0[r]=__builtin_amdgcn_exp2f(P0[r]); }while(0)
  #define RESC() do{ if(resc){ asm volatile("s_waitcnt lgkmcnt(0)":::"memory"); \
      _Pragma("unroll") for(int d_=0;d_<2;++d_) _Pragma("unroll") for(int r=0;r<16;++r)o[d_][r]*=wsf[crow(r,hi)]; } }while(0)
  f32x16 pA0,pA1,pB0,pB1;
  int sl_prev=0,sl_cur=0,sl_next=SLOTB;
  #define ROT() do{sl_prev=sl_cur;sl_cur=sl_next;sl_next=(sl_next==(NSLOT-1)*SLOTB)?0:sl_next+SLOTB;}while(0)
  DMA_K(2,2*SLOTB);
  WAIT_BAR(3);
  qkt(pA0,pA1,Kbase,qr,negm,r32,hi);asm volatile("s_nop 15\n\ts_nop 7":"+v"(pA0),"+v"(pA1));CMASK(pA0,pA1,0);
  START(pA0,pA1);
  _Pragma("unroll") for(int r=0;r<16;++r)pA1[r]=__builtin_amdgcn_exp2f(pA1[r]);
  WAIT_BAR(0);
  DMA_K(3,0);DMA_V(1,SLOTB);
  ROT();
  kload8(kf,kp0+sl_cur);
  WAIT_BAR(2);
  s16x4 vlo[8],vhi[8]; u32x4 pw0,pw1,pw2,pw3;
  #define PKW(P,B) cvtpk_s(P[B],P[B+1])
  #define PAF(k) __builtin_bit_cast(bf16x8,pw##k)
  #define VFR(i) (bf16x8){vlo[i][0],vlo[i][1],vlo[i][2],vlo[i][3],vhi[i][0],vhi[i][1],vhi[i][2],vhi[i][3]}
  #define PIN(x) asm volatile("":"+v"(x))
  #define MX3(a,b,c) __builtin_fmaxf(__builtin_fmaxf((a),(b)),(c))
  #define GAPA(MF,A0,A1,A2,A3,W0,W1,PW) do{ MF; sacc+=A0; sacc+=A1; sacc+=A2; sacc+=A3; PIN(sacc); W0; W1; PIN(PW); SBAR(); }while(0)
  #define EX(v) __builtin_amdgcn_exp2f(v)
  #define GAPB(MF,X,B) do{ MF; X[B]=EX(X[B]); X[B+1]=EX(X[B+1]); X[B+2]=EX(X[B+2]); X[B+3]=EX(X[B+3]); PIN(X); SBAR(); }while(0)
  #define VRD(i) do{ vlo[i]=vtr(vp_+(((i)>>2)*4096+((i)&3)*1024)); vhi[i]=vtr(vp_+(((i)>>2)*4096+((i)&3)*1024+512)); }while(0)
  #define KRD(G,j) do{ if(G){ kload2(kf,kp0+sl_next,j); SBAR(); } }while(0)
  #define STEP(C0,C1,P0,P1,t,GK,GV,GL) do{ SBAR(); \
    const lds_cptr vp_=vp0+sl_prev; \
    VRD(0); SBAR(); float sacc=(P0[0]+P0[1]); \
    GAPA(C0=__builtin_amdgcn_mfma_f32_32x32x16_bf16(kf[0],qr[0],negm,0,0,0), P0[2],P0[3],P0[4],P0[5],     pw0[0]=PKW(P0,0), pw0[1]=PKW(P0,2), pw0); \
    VRD(4); SBAR(); GAPA(C1=__builtin_amdgcn_mfma_f32_32x32x16_bf16(kf[1],qr[0],negm,0,0,0), P0[6],P0[7],P0[8],P0[9],     pw0[2]=PKW(P0,4), pw0[3]=PKW(P0,6), pw0); \
    VRD(1); SBAR(); GAPA(C0=__builtin_amdgcn_mfma_f32_32x32x16_bf16(kf[2],qr[1],C0,0,0,0),   P0[10],P0[11],P0[12],P0[13], pw1[0]=PKW(P0,8), pw1[1]=PKW(P0,10), pw1); \
    VRD(5); SBAR(); GAPA(C1=__builtin_amdgcn_mfma_f32_32x32x16_bf16(kf[3],qr[1],C1,0,0,0),   P0[14],P0[15],P1[0],P1[1],   pw1[2]=PKW(P0,12),pw1[3]=PKW(P0,14), pw1); \
    VRD(2); SBAR(); GAPA(C0=__builtin_amdgcn_mfma_f32_32x32x16_bf16(kf[4],qr[2],C0,0,0,0),   P1[2],P1[3],P1[4],P1[5],     pw2[0]=PKW(P1,0), pw2[1]=PKW(P1,2), pw2); \
    VRD(6); SBAR(); GAPA(C1=__builtin_amdgcn_mfma_f32_32x32x16_bf16(kf[5],qr[2],C1,0,0,0),   P1[6],P1[7],P1[8],P1[9],     pw2[2]=PKW(P1,4), pw2[3]=PKW(P1,6), pw2); \
    VRD(3); SBAR(); GAPA(C0=__builtin_amdgcn_mfma_f32_32x32x16_bf16(kf[6],qr[3],C0,0,0,0),   P1[10],P1[11],P1[12],P1[13], pw3[0]=PKW(P1,8), pw3[1]=PKW(P1,10), pw3); \
    VRD(7); SBAR(); GAPA(C1=__builtin_amdgcn_mfma_f32_32x32x16_bf16(kf[7],qr[3],C1,0,0,0),   P1[14],P1[15],0.f,0.f,       pw3[2]=PKW(P1,12),pw3[3]=PKW(P1,14), pw3); \
    l_reg+=sacc; \
    if(GK){DMA_K((t)+3,sl_cur);} if(GV){DMA_V((t)+1,sl_next);} \
    CMASK(C0,C1,t); \
    { float a=MX3(C0[0],C0[1],C1[0]),b=MX3(C0[2],C0[3],C1[1]); a=MX3(a,C1[2],C1[3]); \
      _Pragma("unroll") for(int r=4;r<16;r+=4){a=MX3(a,C0[r],C0[r+1]);b=MX3(b,C0[r+2],C0[r+3]);a=MX3(a,C1[r],C1[r+1]);b=MX3(b,C1[r+2],C1[r+3]);} \
      float rm=__builtin_fmaxf(a,b); { auto rr=__builtin_amdgcn_permlane32_swap(__float_as_uint(rm),__float_as_uint(rm),false,false); rm=__builtin_fmaxf(__uint_as_float(rr[0]),__uint_as_float(rr[1])); } \
      resc=false; \
      if(__builtin_expect(__any(rm>(float)THRL),0)){ const float dl=__builtin_fmaxf(rm,0.f); mhat+=dl; \
        _Pragma("unroll") for(int r=0;r<16;++r){C0[r]-=dl;C1[r]-=dl;} \
        _Pragma("unroll") for(int r=0;r<16;++r)negm[r]=-mhat; asm volatile("":"+v"(negm)); \
        const float f=__builtin_amdgcn_exp2f(-dl); l_reg*=f; if(hi==0)wsf[r32]=f; resc=true; } } \
    SBAR(); \
    GAPB(o[0]=__builtin_amdgcn_mfma_f32_32x32x16_bf16(PAF(0),VFR(0),o[0],0,0,0), C0,0); \
    GAPB(o[1]=__builtin_amdgcn_mfma_f32_32x32x16_bf16(PAF(0),VFR(4),o[1],0,0,0), C0,4); \
    KRD(GL,0); GAPB(o[0]=__builtin_amdgcn_mfma_f32_32x32x16_bf16(PAF(1),VFR(1),o[0],0,0,0), C0,8); \
    KRD(GL,1); GAPB(o[1]=__builtin_amdgcn_mfma_f32_32x32x16_bf16(PAF(1),VFR(5),o[1],0,0,0), C0,12); \
    KRD(GL,2); GAPB(o[0]=__builtin_amdgcn_mfma_f32_32x32x16_bf16(PAF(2),VFR(2),o[0],0,0,0), C1,0); \
    KRD(GL,3); GAPB(o[1]=__builtin_amdgcn_mfma_f32_32x32x16_bf16(PAF(2),VFR(6),o[1],0,0,0), C1,4); \
    GAPB(o[0]=__builtin_amdgcn_mfma_f32_32x32x16_bf16(PAF(3),VFR(3),o[0],0,0,0), C1,8); \
    GAPB(o[1]=__builtin_amdgcn_mfma_f32_32x32x16_bf16(PAF(3),VFR(7),o[1],0,0,0), C1,12); \
    }while(0)
  int t=1;
  #undef CMASK
  #define CMASK(P0,P1,t) do{}while(0)
  for(;t+5<NT;t+=2){
    STEP(pB0,pB1,pA0,pA1,t,true,true,true);     WAIT_BAR(2); RESC(); ROT();
    STEP(pA0,pA1,pB0,pB1,t+1,true,true,true);   WAIT_BAR(2); RESC(); ROT();
  }
  #undef CMASK
  #define CMASK(P0,P1,t) do{int jb_=(t)-(NT-4); if(jb_>=0)cmask(P0,P1,jb_,qrel,hi);}while(0)
  #define ENDW(tt) do{ if((tt)+3<NT){WAIT_BAR(2);} else if((tt)+2<NT){WAIT_BAR(1);} else {WAIT_BAR(0);} }while(0)
  for(;t+1<NT;t+=2){
    STEP(pB0,pB1,pA0,pA1,t,(t+3<NT),(t+1<NT),(t+1<NT));       ENDW(t);   RESC(); ROT();
    STEP(pA0,pA1,pB0,pB1,t+1,(t+4<NT),(t+2<NT),(t+2<NT));     ENDW(t+1); RESC(); ROT();
  }
  STEP(pB0,pB1,pA0,pA1,NT-1,false,false,false); RESC();
  { float sacc=pB0[0]+pB0[1]; _Pragma("unroll") for(int r=2;r<16;++r)sacc+=pB0[r]; _Pragma("unroll") for(int r=0;r<16;++r)sacc+=pB1[r]; l_reg+=sacc;
    pw0=(u32x4){PKW(pB0,0),PKW(pB0,2),PKW(pB0,4),PKW(pB0,6)};pw1=(u32x4){PKW(pB0,8),PKW(pB0,10),PKW(pB0,12),PKW(pB0,14)};pw2=(u32x4){PKW(pB1,0),PKW(pB1,2),PKW(pB1,4),PKW(pB1,6)};pw3=(u32x4){PKW(pB1,8),PKW(pB1,10),PKW(pB1,12),PKW(pB1,14)};
    SBAR(); pv(o,vb0+sl_cur,PAF(0),PAF(1),PAF(2),PAF(3)); }
  #undef PKW
  #undef PAF
  #undef VFR
  #undef PIN
  #undef MX3
  #undef GAPA
  #undef GAPB
  #undef EX
  #undef VRD
  #undef KRD
  #undef STEP
  #undef ENDW
  {auto rr=__builtin_amdgcn_permlane32_swap(__float_as_uint(l_reg),__float_as_uint(l_reg),false,false);l_reg=__uint_as_float(rr[0])+__uint_as_float(rr[1]);}
  if(hi==0)wsf[32+r32]=l_reg;asm volatile("s_waitcnt lgkmcnt(0)":::"memory");
  float rli[16];
  #pragma unroll
  for(int r=0;r<16;++r)rli[r]=__builtin_amdgcn_rcpf(wsf[32+crow(r,hi)]);
  bf16*Ow=O+(rowbase+q0+wid*QBLK)*DM+hv*D;
  { bf16*stg=(bf16*)(shm+LDS_OST)+wid*2048;
    #pragma unroll
    for(int r=0;r<16;++r){const int orow=crow(r,hi);
      #pragma unroll
      for(int d0=0;d0<2;++d0)stg[orow*64+d0*32+r32]=__float2bfloat16(o[d0][r]*rli[r]);}
    asm volatile("s_waitcnt lgkmcnt(0)":::"memory");
    #pragma unroll
    for(int i=0;i<4;++i){const int row=i*8+(lane>>3),ch=lane&7; const u32x4 v=*(const u32x4*)(stg+row*64+ch*8); ATTN_STORE16(Ow+(long)row*DM+ch*8,v);} }
  asm volatile("s_waitcnt lgkmcnt(0)\n\ts_barrier":::"memory");
  #undef DMA_K
  #undef DMA_V
  #undef CMASK
  #undef START
  #undef RESC
  #undef ROT
}
constexpr int ATTN_LDS_BYTES=LDS_BYTES;
struct AttnTensors { const bf16* Q; const bf16* K; const bf16* V; bf16* O1; bf16* O2; };
struct AttnUnit { int combo; int qb; };
struct StaticOrder {
  int vcu,G,blk;
  __device__ __forceinline__ explicit StaticOrder(int grid,int block):vcu((grid%8==0)?(block%8)*(grid/8)+block/8:block),G(grid),blk(block){}
  __device__ __forceinline__ bool next(int i,AttnUnit&u)const{
    if(G==256){ if(i>=32)return false; const int s=vcu&7,j=i&3; u.combo=(i>>2)*32+(vcu>>3); u.qb=(j==0)?s:(j==1)?15-s:(j==2)?16+s:31-s; return true; }
    const long L=(long)i*G+blk; if(L>=8192)return false; u.combo=(int)(L>>5); u.qb=31-(int)(L&31); return true; }
};
template<class Sched,int THRL=8> __device__ __forceinline__ void attn_phase(char*lds,const AttnTensors&T,const Sched&S){
  AttnUnit u;
  for(int i=0;S.next(i,u);++i){ const int b=u.combo>>5,hq=(u.combo>>1)&15,vh=u.combo&1; const int hv=(hq>>1)*2+vh;
    attn_unit<THRL>(b,hq,hv,u.qb,T.Q,T.K,T.V,(hq&1)?T.O2:T.O1,lds); }
}
#undef SBAR
#undef WAIT_BAR
}

#include <hip/hip_cooperative_groups.h>
namespace cg = cooperative_groups;

constexpr int NWAVES = 8;
#ifndef STOP_AFTER
#define STOP_AFTER 99
#endif
constexpr int DM = 1024, FF = 4096, NP = 65536, NS = 256, M = NP + NS;
constexpr float EPS = 1e-6f;
constexpr float LAM_INIT = 0.35550906759f;
constexpr size_t O_Y = 0, O_KP = (size_t)M * DM, O_VP = O_KP + (size_t)NP * DM, O_STP = O_VP + (size_t)NP * DM, O_KS = O_STP + (size_t)8 * 8 * 128 * 128,
                 O_VS = O_KS + (size_t)NS * DM, O_STS = O_VS + (size_t)NS * DM, O_END = O_STS + (size_t)16 * 8 * 128 * 128;
constexpr size_t MiB = 1u << 20;
constexpr size_t WS_OML = 1 * MiB;
constexpr size_t WS_WIN = 2 * MiB, WS_WHO = 10 * MiB, WS_WUP0 = 12 * MiB, WS_WDN0 = 20 * MiB, WS_WQKV = 28 * MiB, WS_WDO = 34 * MiB, WS_WUP1 = 36 * MiB, WS_WDN1 = 44 * MiB;
constexpr size_t WS_XN = 64 * MiB;
constexpr size_t WS_MB = 196 * MiB;
constexpr size_t WS_R0 = 328 * MiB;
constexpr size_t WS_Q = WS_R0, WS_K = WS_R0 + 130 * MiB, WS_V = WS_R0 + 260 * MiB, WS_O1 = WS_R0 + 390 * MiB;
constexpr size_t WS_O2 = WS_R0 + 520 * MiB;
constexpr size_t WS_PACC = WS_O2 + 130 * MiB;
constexpr size_t WS_END = WS_PACC + 4 * MiB;
constexpr int SPLK = 4;
constexpr size_t WS_RS = 1 * MiB + 65536;
static_assert(WS_O2 + (size_t)M * DM * 2 <= WS_END && WS_END <= 1024 * MiB && WS_O1 + (size_t)M * DM * 2 <= WS_O2 && WS_R0 + (size_t)M * FF * 2 <= WS_END && WS_XN + (size_t)M * DM * 2 <= WS_MB && WS_MB + (size_t)M * DM * 2 <= WS_R0, "d_ws map");

constexpr int RING_OFF = 0, RING_BYTES = 131072;
constexpr int LDS_BYTES = 155648;

#define GAS __attribute__((address_space(1)))
#define LAS __attribute__((address_space(3)))
typedef unsigned short bf16;
typedef unsigned v4u __attribute__((ext_vector_type(4)));
typedef unsigned v2u __attribute__((ext_vector_type(2)));
typedef float f32x4 __attribute__((ext_vector_type(4)));
typedef short bf16x8 __attribute__((ext_vector_type(8)));
#define LDS_WAIT() asm volatile("s_waitcnt lgkmcnt(0)" ::: "memory")
__device__ __forceinline__ unsigned pk2(float lo, float hi) { return pg8::cvt_pk_bf16(lo, hi); }
__device__ __forceinline__ float bf2f(unsigned short u) { return __uint_as_float((unsigned)u << 16); }
__device__ __forceinline__ float bflo(unsigned u) { return __uint_as_float(u << 16); }
__device__ __forceinline__ float bfhi(unsigned u) { return __uint_as_float(u & 0xffff0000u); }
template <int CTRL> __device__ __forceinline__ float dpp_f(float v) { return __builtin_bit_cast(float, __builtin_amdgcn_update_dpp(0, __builtin_bit_cast(int, v), CTRL, 0xf, 0xf, true)); }
__device__ __forceinline__ float wave_sum(float v) {
#pragma unroll
    for (int o = 1; o < 64; o <<= 1) v += __shfl_xor(v, o);
    return v;
}
__device__ __forceinline__ float wave_max(float v) {
#pragma unroll
    for (int o = 1; o < 64; o <<= 1) v = fmaxf(v, __shfl_xor(v, o));
    return v;
}

struct Frame {
    LAS unsigned char* lds;
    int tid, lane, wave, vcu, G;
};

__device__ __forceinline__ void p0_transpose_item(const float* W, const float* gain, int K, int N, bf16* WT, int row_off, LAS float* scr, int item, int lane) {
    const int nblk = N / 32, kb = item / nblk, nb = item % nblk, k0 = 64 * kb, n0 = 32 * nb;
    if (gain) {
        float wv[32], gv[32];
#pragma unroll
        for (int i = 0; i < 32; ++i) { const int kk = 2 * i + (lane >> 5); wv[i] = W[(size_t)(k0 + kk) * N + n0 + (lane & 31)]; gv[i] = gain[k0 + kk]; }
#pragma unroll
        for (int i = 0; i < 32; ++i) { const int kk = 2 * i + (lane >> 5); scr[kk * 33 + (lane & 31)] = gv[i] * wv[i]; }
    } else {
        float wv[32];
#pragma unroll
        for (int i = 0; i < 32; ++i) { const int kk = 2 * i + (lane >> 5); wv[i] = W[(size_t)(k0 + kk) * N + n0 + (lane & 31)]; }
#pragma unroll
        for (int i = 0; i < 32; ++i) { const int kk = 2 * i + (lane >> 5); scr[kk * 33 + (lane & 31)] = wv[i]; }
    }
    LDS_WAIT(); asm volatile("" ::: "memory");
    const int c = lane & 7;
#pragma unroll
    for (int j = 0; j < 4; ++j) { const int n = (lane >> 3) + 8 * j; const LAS float* s = scr + (8 * c) * 33 + n;
        v4u o; o.x = pk2(s[0 * 33], s[1 * 33]); o.y = pk2(s[2 * 33], s[3 * 33]); o.z = pk2(s[4 * 33], s[5 * 33]); o.w = pk2(s[6 * 33], s[7 * 33]);
        *(v4u*)(WT + (size_t)(row_off + n0 + n) * K + k0 + 8 * c) = o; }
    LDS_WAIT(); asm volatile("" ::: "memory");
}

struct Args {
    const float* in[18]; float* out; unsigned char* ws;
};

__device__ __forceinline__ void rms_row_to_bf16(const float* xrow, bf16* orow, float* rs, int lane) {
    const f32x4* xr = (const f32x4*)xrow;
    f32x4 v[4]; v[0] = xr[2 * lane]; v[1] = xr[2 * lane + 1]; v[2] = xr[128 + 2 * lane]; v[3] = xr[128 + 2 * lane + 1];
    float s = 0.f;
#pragma unroll
    for (int j = 0; j < 4; ++j) s += (v[j].x * v[j].x + v[j].y * v[j].y) + (v[j].z * v[j].z + v[j].w * v[j].w);
    const float ms = wave_sum(s) * (1.f / DM) + EPS; const float r = rsqrtf(ms);
    if (lane == 0) *rs = sqrtf(ms);
    v4u o0, o1;
    o0.x = pk2(v[0].x * r, v[0].y * r); o0.y = pk2(v[0].z * r, v[0].w * r); o0.z = pk2(v[1].x * r, v[1].y * r); o0.w = pk2(v[1].z * r, v[1].w * r);
    o1.x = pk2(v[2].x * r, v[2].y * r); o1.y = pk2(v[2].z * r, v[2].w * r); o1.z = pk2(v[3].x * r, v[3].y * r); o1.w = pk2(v[3].z * r, v[3].w * r);
    *(v4u*)(orow + 8 * lane) = o0; *(v4u*)(orow + 512 + 8 * lane) = o1;
}

template <bool LAST>
__device__ __forceinline__ void norm_phase(const Frame& F, const bf16* MB, const float* pacc, const float* gpost, float* RS, float* out, bf16* XN) {
    const int gw = F.vcu * NWAVES + F.wave, NGW = F.G * NWAVES, lane = F.lane;
    f32x4 g[4]; { const f32x4* gp = (const f32x4*)gpost; g[0] = gp[2 * lane]; g[1] = gp[2 * lane + 1]; g[2] = gp[128 + 2 * lane]; g[3] = gp[128 + 2 * lane + 1]; }
    for (int row = gw; row < M; row += NGW) {
        const v4u m0 = *(const v4u*)(MB + (size_t)row * DM + 8 * lane), m1 = *(const v4u*)(MB + (size_t)row * DM + 512 + 8 * lane);
        const v4u x0 = *(const v4u*)(XN + (size_t)row * DM + 8 * lane), x1 = *(const v4u*)(XN + (size_t)row * DM + 512 + 8 * lane);
        const float hs = RS[row];
        f32x4 v[4], mm[4];
        v[0] = (f32x4){bflo(x0.x), bfhi(x0.x), bflo(x0.y), bfhi(x0.y)}; v[1] = (f32x4){bflo(x0.z), bfhi(x0.z), bflo(x0.w), bfhi(x0.w)};
        v[2] = (f32x4){bflo(x1.x), bfhi(x1.x), bflo(x1.y), bfhi(x1.y)}; v[3] = (f32x4){bflo(x1.z), bfhi(x1.z), bflo(x1.w), bfhi(x1.w)};
        mm[0] = (f32x4){bflo(m0.x), bfhi(m0.x), bflo(m0.y), bfhi(m0.y)}; mm[1] = (f32x4){bflo(m0.z), bfhi(m0.z), bflo(m0.w), bfhi(m0.w)};
        mm[2] = (f32x4){bflo(m1.x), bfhi(m1.x), bflo(m1.y), bfhi(m1.y)}; mm[3] = (f32x4){bflo(m1.z), bfhi(m1.z), bflo(m1.w), bfhi(m1.w)};
        if (row >= NP) {
            const f32x4* pp = (const f32x4*)(pacc + (size_t)(row - NP) * DM);
            mm[0] = pp[2 * lane]; mm[1] = pp[2 * lane + 1]; mm[2] = pp[128 + 2 * lane]; mm[3] = pp[128 + 2 * lane + 1];
#pragma unroll
            for (int p = 1; p < SPLK; ++p) { const f32x4* pq_ = pp + (size_t)p * (NS * DM / 4); mm[0] += pq_[2 * lane]; mm[1] += pq_[2 * lane + 1]; mm[2] += pq_[128 + 2 * lane]; mm[3] += pq_[128 + 2 * lane + 1]; }
        }
        float s = 0.f;
#pragma unroll
        for (int j = 0; j < 4; ++j) s += (mm[j].x * mm[j].x + mm[j].y * mm[j].y) + (mm[j].z * mm[j].z + mm[j].w * mm[j].w);
        const float r = rsqrtf(wave_sum(s) * (1.f / DM) + EPS);
        float s2 = 0.f;
#pragma unroll
        for (int j = 0; j < 4; ++j) { v[j] = v[j] * hs + mm[j] * r * g[j]; s2 += (v[j].x * v[j].x + v[j].y * v[j].y) + (v[j].z * v[j].z + v[j].w * v[j].w); }
        if (LAST) {
            f32x4* dr = (f32x4*)(out + (size_t)row * DM);
            dr[2 * lane] = v[0]; dr[2 * lane + 1] = v[1]; dr[128 + 2 * lane] = v[2]; dr[128 + 2 * lane + 1] = v[3];
        } else {
            const float ms = wave_sum(s2) * (1.f / DM) + EPS; const float r2 = rsqrtf(ms);
            if (lane == 0) RS[row] = sqrtf(ms);
            v4u o0, o1;
            o0.x = pk2(v[0].x * r2, v[0].y * r2); o0.y = pk2(v[0].z * r2, v[0].w * r2); o0.z = pk2(v[1].x * r2, v[1].y * r2); o0.w = pk2(v[1].z * r2, v[1].w * r2);
            o1.x = pk2(v[2].x * r2, v[2].y * r2); o1.y = pk2(v[2].z * r2, v[2].w * r2); o1.z = pk2(v[3].x * r2, v[3].y * r2); o1.w = pk2(v[3].z * r2, v[3].w * r2);
            *(v4u*)(XN + (size_t)row * DM + 8 * lane) = o0; *(v4u*)(XN + (size_t)row * DM + 512 + 8 * lane) = o1;
        }
    }
}

__device__ __forceinline__ float compute_lam(const float* lp, int lane) {
    const float a = wave_sum(lp[lane] * lp[64 + lane]), b = wave_sum(lp[128 + lane] * lp[192 + lane]);
    return __expf(a) - __expf(b) + LAM_INIT;
}

__device__ __forceinline__ void combine_phase(const Frame& F, const bf16* O1, const bf16* O2, const float* lp, const float* subg, bf16* OC) {
    const int gw = F.vcu * NWAVES + F.wave, NGW = F.G * NWAVES, lane = F.lane;
    const float lam = compute_lam(lp, lane);
    float sg[16];
#pragma unroll
    for (int e = 0; e < 16; ++e) sg[e] = subg[16 * (lane & 7) + e] * (1.0f - LAM_INIT);
    for (int row = gw; row < NP; row += NGW) {
        const size_t off = (size_t)row * DM + 16 * lane;
        const v4u a0 = *(const v4u*)(O1 + off), a1 = *(const v4u*)(O1 + off + 8), b0 = *(const v4u*)(O2 + off), b1 = *(const v4u*)(O2 + off + 8);
        float o[16];
        const unsigned aw[8] = {a0.x, a0.y, a0.z, a0.w, a1.x, a1.y, a1.z, a1.w}, bw[8] = {b0.x, b0.y, b0.z, b0.w, b1.x, b1.y, b1.z, b1.w};
        float s = 0.f;
#pragma unroll
        for (int e = 0; e < 8; ++e) { o[2 * e] = bflo(aw[e]) - lam * bflo(bw[e]); o[2 * e + 1] = bfhi(aw[e]) - lam * bfhi(bw[e]); s += o[2 * e] * o[2 * e] + o[2 * e + 1] * o[2 * e + 1]; }
        s += __shfl_xor(s, 1); s += __shfl_xor(s, 2); s += __shfl_xor(s, 4);
        const float r = rsqrtf(s * (1.f / 128.f) + EPS);
        v4u w0, w1;
        w0.x = pk2(o[0] * r * sg[0], o[1] * r * sg[1]); w0.y = pk2(o[2] * r * sg[2], o[3] * r * sg[3]); w0.z = pk2(o[4] * r * sg[4], o[5] * r * sg[5]); w0.w = pk2(o[6] * r * sg[6], o[7] * r * sg[7]);
        w1.x = pk2(o[8] * r * sg[8], o[9] * r * sg[9]); w1.y = pk2(o[10] * r * sg[10], o[11] * r * sg[11]); w1.z = pk2(o[12] * r * sg[12], o[13] * r * sg[13]); w1.w = pk2(o[14] * r * sg[14], o[15] * r * sg[15]);
        *(v4u*)(OC + off) = w0; *(v4u*)(OC + off + 8) = w1;
    }
}

namespace hg {
#define HGT 0
constexpr int QT_P = 136, KH_P = 72, ST_P = 136;
constexpr int L_QT = 0, L_KT = 17408, L_KHT = 34816, L_VT = 53248, L_AM = 71680, L_ST = 80896, L_BSUM = 115712, L_DL = 117760, L_SSQ = 118272, L_OST = 118784, OST_P = 72, L_RV = L_OST + 8 * 16 * OST_P * 2, L_END = L_RV + 64 * QT_P * 2;
static_assert(L_END <= LDS_BYTES, "hgrn LDS");
#define HG_MFMA(a, b, c) __builtin_amdgcn_mfma_f32_16x16x32_bf16((a), (b), (c), 0, 0, 0)
template <int ntok>
__device__ __forceinline__ void hgrn_item(LAS unsigned char* lds, const bf16* HG, bf16* OUT, const float* S0, float* Sout, long row0, int nchunk, int h, const float* onorm_g) {
    int tid_ = threadIdx.x; asm volatile("" : "+v"(tid_));
    const int tid = tid_, lane = tid & 63, wid = __builtin_amdgcn_readfirstlane(tid >> 6);
    const int kc = tid & 127, qt = wid >> 1, fr = lane & 15, fq = lane >> 4;
    LAS bf16* Qt = (LAS bf16*)(lds + L_QT); LAS bf16* Kt = (LAS bf16*)(lds + L_KT); LAS bf16* KhT = (LAS bf16*)(lds + L_KHT); LAS bf16* VT = (LAS bf16*)(lds + L_VT);
    LAS bf16* Am = (LAS bf16*)(lds + L_AM); LAS bf16* ST = (LAS bf16*)(lds + L_ST);
    LAS bf16* ost = (LAS bf16*)(lds + L_OST) + wid * (16 * OST_P);
    LAS float* bsum = (LAS float*)(lds + L_BSUM); LAS float* dlast = (LAS float*)(lds + L_DL); LAS float* ssq = (LAS float*)(lds + L_SSQ);
    const int ti = wid >> 1, vh = wid & 1;
    f32x4 sacc[8];
#pragma unroll
    for (int vt = 0; vt < 8; ++vt) {
#pragma unroll
        for (int i = 0; i < 4; ++i) sacc[vt][i] = S0 ? S0[(size_t)(16 * wid + 4 * fq + i) * 128 + 16 * vt + fr] : 0.f;
    }
    __syncthreads();
#pragma unroll
    for (int vt = 0; vt < 8; ++vt) { v2u w; w.x = pk2(sacc[vt][0], sacc[vt][1]); w.y = pk2(sacc[vt][2], sacc[vt][3]); *(LAS v2u*)(ST + (16 * vt + fr) * ST_P + 16 * wid + 4 * fq) = w; }
    float og[4];
#pragma unroll
    for (int j = 0; j < 4; ++j) og[j] = onorm_g[h * 128 + 16 * (4 * vh + j) + fr];
    LAS bf16* RV = (LAS bf16*)(lds + L_RV);
    v4u pq[2], pk[2], pv[2], pg[2];
#define HG_LOAD(c) do { _Pragma("unroll") for (int e = 0; e < 2; ++e) { const int id = tid + 512 * e, r_ = id >> 4, pc = id & 15; const int rc = (ntok >= 64 || r_ < ntok) ? r_ : ntok - 1; \
            const bf16* p = HG + (size_t)(row0 + (long)(c) * 64 + rc) * 4096 + h * 128 + pc * 8; pq[e] = *(const v4u*)p; pk[e] = *(const v4u*)(p + 1024); pv[e] = *(const v4u*)(p + 2048); } \
        _Pragma("unroll") for (int hh = 0; hh < 2; ++hh) { const int r_ = 16 * ti + (lane >> 2); const int rc = (ntok >= 64 || r_ < ntok) ? r_ : ntok - 1; \
            pg[hh] = *(const v4u*)(HG + (size_t)(row0 + (long)(c) * 64 + rc) * 4096 + 3072 + h * 128 + 64 * vh + 8 * ((lane & 3) + 4 * hh)); } } while (0)
    HG_LOAD(0);
    for (int c = 0; c < nchunk; ++c) {
        float q[16], k[16]; unsigned vpk[8]; v4u gcur[2];
#pragma unroll
        for (int e = 0; e < 2; ++e) { const int id = tid + 512 * e, r_ = id >> 4, pc = id & 15;
            *(LAS v4u*)(Qt + r_ * QT_P + pc * 8) = pq[e]; *(LAS v4u*)(Kt + r_ * QT_P + pc * 8) = pk[e]; *(LAS v4u*)(RV + r_ * QT_P + pc * 8) = pv[e]; }
        gcur[0] = pg[0]; gcur[1] = pg[1];
        if (c + 1 < nchunk) HG_LOAD(c + 1);
        __syncthreads();
        { unsigned short rv[16];
#pragma unroll
          for (int i = 0; i < 16; ++i) { const bool ok = (ntok >= 64) || (16 * qt + i) < ntok; const int o_ = (16 * qt + i) * QT_P + kc;
              const unsigned short tq_ = Qt[o_], tk_ = Kt[o_], tv_ = RV[o_]; q[i] = ok ? bf2f(tq_) : 0.f; k[i] = ok ? bf2f(tk_) : 0.f; rv[i] = ok ? tv_ : (unsigned short)0; }
#pragma unroll
          for (int i = 0; i < 8; ++i) vpk[i] = (unsigned)rv[2 * i] | ((unsigned)rv[2 * i + 1] << 16); }
        float g[16]; float run = 1.f;
#pragma unroll
        for (int i = 0; i < 16; ++i) { run *= (1.0f - k[i]); g[i] = run; }
        bsum[qt * 128 + kc] = run;
        __syncthreads();
        float off = 1.f, tot = 1.f;
#pragma unroll
        for (int j = 0; j < 4; ++j) { const float s_ = bsum[j * 128 + kc]; tot *= s_; off *= (j < qt) ? s_ : 1.f; }
        unsigned khp[8];
#pragma unroll
        for (int i = 0; i < 16; i += 2) {
            const float p0 = off * g[i], p1 = off * g[i + 1]; const float r0 = __builtin_amdgcn_rcpf(p0), r1 = __builtin_amdgcn_rcpf(p1);
            const unsigned qq = pk2(q[i] * p0, q[i + 1] * p1), kk = pk2(k[i] * r0, k[i + 1] * r1);
            Qt[(16 * qt + i) * QT_P + kc] = (bf16)(qq & 0xffffu); Qt[(16 * qt + i + 1) * QT_P + kc] = (bf16)(qq >> 16);
            Kt[(16 * qt + i) * QT_P + kc] = (bf16)(kk & 0xffffu); Kt[(16 * qt + i + 1) * QT_P + kc] = (bf16)(kk >> 16);
            khp[i >> 1] = pk2(k[i] * (tot * r0), k[i + 1] * (tot * r1));
        }
        *(LAS v4u*)(KhT + kc * KH_P + 16 * qt) = (v4u){khp[0], khp[1], khp[2], khp[3]}; *(LAS v4u*)(KhT + kc * KH_P + 16 * qt + 8) = (v4u){khp[4], khp[5], khp[6], khp[7]};
        *(LAS v4u*)(VT + kc * KH_P + 16 * qt) = (v4u){vpk[0], vpk[1], vpk[2], vpk[3]}; *(LAS v4u*)(VT + kc * KH_P + 16 * qt + 8) = (v4u){vpk[4], vpk[5], vpk[6], vpk[7]};
        if (qt == 0) dlast[kc] = tot;
        __syncthreads();
        { bf16x8 af[4];
#pragma unroll
          for (int kk = 0; kk < 4; ++kk) af[kk] = *(const LAS bf16x8*)(Qt + (16 * ti + fr) * QT_P + 32 * kk + 8 * fq);
#pragma unroll
          for (int jj = 0; jj < 2; ++jj) { const int sj = 2 * vh + jj;
            f32x4 a = (f32x4){0.f, 0.f, 0.f, 0.f};
            if (sj <= ti) { bf16x8 bfr[4];
#pragma unroll
                for (int kk = 0; kk < 4; ++kk) bfr[kk] = *(const LAS bf16x8*)(Kt + (16 * sj + fr) * QT_P + 32 * kk + 8 * fq);
                __builtin_amdgcn_sched_barrier(0);
#pragma unroll
                for (int kk = 0; kk < 4; ++kk) a = HG_MFMA(af[kk], bfr[kk], a);
            }
#pragma unroll
            for (int i = 0; i < 4; ++i) { const int t = 16 * ti + 4 * fq + i, s_ = 16 * sj + fr; const float val = (s_ <= t) ? a[i] : 0.f; Am[t * KH_P + s_] = (bf16)(pk2(val, 0.f) & 0xffffu); }
          } }
        __syncthreads();
        f32x4 oacc[4];
        { bf16x8 aA[2], aQ[4], bb[2][6];
#pragma unroll
          for (int kk = 0; kk < 2; ++kk) aA[kk] = *(const LAS bf16x8*)(Am + (16 * ti + fr) * KH_P + 32 * kk + 8 * fq);
#pragma unroll
          for (int kk = 0; kk < 4; ++kk) aQ[kk] = *(const LAS bf16x8*)(Qt + (16 * ti + fr) * QT_P + 32 * kk + 8 * fq);
#define HG_LDB(dst, vt_) do { _Pragma("unroll") for (int kk = 0; kk < 2; ++kk) dst[kk] = *(const LAS bf16x8*)(VT + (16 * (vt_) + fr) * KH_P + 32 * kk + 8 * fq); \
              _Pragma("unroll") for (int kk = 0; kk < 4; ++kk) dst[2 + kk] = *(const LAS bf16x8*)(ST + (16 * (vt_) + fr) * ST_P + 32 * kk + 8 * fq); } while (0)
          HG_LDB(bb[0], 4 * vh);
#pragma unroll
          for (int j = 0; j < 4; ++j) { f32x4 o = (f32x4){0.f, 0.f, 0.f, 0.f};
              if (j + 1 < 4) HG_LDB(bb[(j + 1) & 1], 4 * vh + j + 1);
              __builtin_amdgcn_sched_barrier(0);
#pragma unroll
              for (int kk = 0; kk < 2; ++kk) o = HG_MFMA(aA[kk], bb[j & 1][kk], o);
#pragma unroll
              for (int kk = 0; kk < 4; ++kk) o = HG_MFMA(aQ[kk], bb[j & 1][2 + kk], o);
              oacc[j] = o; }
#undef HG_LDB
        }
#pragma unroll
        for (int i = 0; i < 4; ++i) { float p = 0.f;
#pragma unroll
            for (int j = 0; j < 4; ++j) p += oacc[j][i] * oacc[j][i];
            p += dpp_f<0xB1>(p); p += dpp_f<0x4E>(p); p += dpp_f<0x124>(p); p += dpp_f<0x128>(p);
            if (fr == 0) ssq[vh * 64 + 16 * ti + 4 * fq + i] = p; }
        __syncthreads();
#pragma unroll
        for (int i = 0; i < 4; ++i) { const int t = 16 * ti + 4 * fq + i; const float r = rsqrtf((ssq[t] + ssq[64 + t]) * (1.f / 128.f) + EPS);
#pragma unroll
            for (int j = 0; j < 4; ++j) ost[(4 * fq + i) * OST_P + 16 * j + fr] = (bf16)(pk2(oacc[j][i] * r * og[j], 0.f) & 0xffffu); }
        asm volatile("s_waitcnt lgkmcnt(0)" ::: "memory");
#pragma unroll
        for (int hh = 0; hh < 2; ++hh) { const int orow = lane >> 2, och = (lane & 3) + 4 * hh; const v4u w = *(const LAS v4u*)(ost + orow * OST_P + 8 * och); const v4u gg = gcur[hh];
            v4u o4; o4.x = pk2(bflo(w.x) * bflo(gg.x), bfhi(w.x) * bfhi(gg.x)); o4.y = pk2(bflo(w.y) * bflo(gg.y), bfhi(w.y) * bfhi(gg.y));
            o4.z = pk2(bflo(w.z) * bflo(gg.z), bfhi(w.z) * bfhi(gg.z)); o4.w = pk2(bflo(w.w) * bflo(gg.w), bfhi(w.w) * bfhi(gg.w));
            if (ntok >= 64 || 16 * ti + orow < ntok) *(v4u*)(OUT + (size_t)(row0 + (long)c * 64 + 16 * ti + orow) * DM + h * 128 + 64 * vh + 8 * och) = o4; }
        asm volatile("s_waitcnt lgkmcnt(0)" ::: "memory");
        { float d[4];
#pragma unroll
          for (int i = 0; i < 4; ++i) d[i] = dlast[16 * wid + 4 * fq + i];
          bf16x8 aK[2];
#pragma unroll
          for (int kk = 0; kk < 2; ++kk) aK[kk] = *(const LAS bf16x8*)(KhT + (16 * wid + fr) * KH_P + 32 * kk + 8 * fq);
#pragma unroll
          for (int g4 = 0; g4 < 2; ++g4) { bf16x8 bv[4][2];
#pragma unroll
              for (int u = 0; u < 4; ++u)
#pragma unroll
                  for (int kk = 0; kk < 2; ++kk) bv[u][kk] = *(const LAS bf16x8*)(VT + (16 * (4 * g4 + u) + fr) * KH_P + 32 * kk + 8 * fq);
              __builtin_amdgcn_sched_barrier(0);
#pragma unroll
              for (int u = 0; u < 4; ++u) { const int vt = 4 * g4 + u; f32x4 a = sacc[vt];
#pragma unroll
                  for (int i = 0; i < 4; ++i) a[i] *= d[i];
#pragma unroll
                  for (int kk = 0; kk < 2; ++kk) a = HG_MFMA(aK[kk], bv[u][kk], a);
                  sacc[vt] = a;
                  v2u w; w.x = pk2(a[0], a[1]); w.y = pk2(a[2], a[3]); *(LAS v2u*)(ST + (16 * vt + fr) * ST_P + 16 * wid + 4 * fq) = w; } } }
    }
#undef HG_LOAD
#pragma unroll
    for (int vt = 0; vt < 8; ++vt) {
#pragma unroll
        for (int i = 0; i < 4; ++i) Sout[(size_t)(16 * wid + 4 * fq + i) * 128 + 16 * vt + fr] = sacc[vt][i];
    }
    __syncthreads();
}
}

namespace sa {
constexpr int SCP = 1044, NQ = 8;
constexpr int L_Q = 0, L_SC = 8192, L_OACC = L_SC + NQ * SCP * 4, L_O0 = L_OACC + 4 * NQ * 128 * 4, L_END = L_O0 + NQ * 128 * 4;
static_assert(L_END <= RING_BYTES, "sample attention LDS");
__device__ __forceinline__ void item(LAS unsigned char* lds, int it2, const bf16* Qb, const bf16* Kb, const bf16* Vb, const float* ck, const float* cv, bf16* OC, float lam, const float* subg) {
    int tid_ = threadIdx.x; asm volatile("" : "+v"(tid_));
    const int tid = tid_, lane = tid & 63, wid = __builtin_amdgcn_readfirstlane(tid >> 6);
    const int it = it2 >> 1, q0 = (it2 & 1) * NQ, b = it >> 3, h = it & 7;
    LAS float* Qs = (LAS float*)(lds + L_Q); LAS float* SC = (LAS float*)(lds + L_SC); LAS float* OA = (LAS float*)(lds + L_OACC); LAS float* O0 = (LAS float*)(lds + L_O0);
    const size_t srow = (size_t)NP + (size_t)b * 16;
    __syncthreads();
    if (tid < 256) { const int idx = tid * 4, c = idx >> 9, qq = (idx >> 6) & 7, d = idx & 63;
      const v2u w = *(const v2u*)(Qb + (srow + q0 + qq) * DM + h * 128 + c * 64 + d);
      Qs[idx] = bflo(w.x); Qs[idx + 1] = bfhi(w.x); Qs[idx + 2] = bflo(w.y); Qs[idx + 3] = bfhi(w.y); }
    __syncthreads();
    for (int c = 0; c < 2; ++c) {
        for (int key = tid; key < 1040; key += 512) {
            float s[NQ];
            float kd[64];
            if (key < 1024) { const f32x4* kp = (const f32x4*)(ck + (((size_t)b * 1024 + key) * 8 + h) * 128 + c * 64);
#pragma unroll
                for (int j = 0; j < 16; ++j) { const f32x4 t4 = kp[j]; kd[4 * j] = t4.x; kd[4 * j + 1] = t4.y; kd[4 * j + 2] = t4.z; kd[4 * j + 3] = t4.w; } }
            else { const v4u* kp = (const v4u*)(Kb + (srow + (key - 1024)) * DM + h * 128 + c * 64);
#pragma unroll
                for (int j = 0; j < 8; ++j) { const v4u t4 = kp[j]; kd[8 * j] = bflo(t4.x); kd[8 * j + 1] = bfhi(t4.x); kd[8 * j + 2] = bflo(t4.y); kd[8 * j + 3] = bfhi(t4.y);
                    kd[8 * j + 4] = bflo(t4.z); kd[8 * j + 5] = bfhi(t4.z); kd[8 * j + 6] = bflo(t4.w); kd[8 * j + 7] = bfhi(t4.w); } }
#pragma unroll
            for (int qq = 0; qq < NQ; ++qq) { const LAS f32x4* qp = (const LAS f32x4*)(Qs + c * (NQ * 64) + qq * 64); float a = 0.f;
#pragma unroll
                for (int j = 0; j < 16; ++j) { const f32x4 q4 = qp[j]; a += (kd[4 * j] * q4.x + kd[4 * j + 1] * q4.y) + (kd[4 * j + 2] * q4.z + kd[4 * j + 3] * q4.w); }
                s[qq] = a; }
#pragma unroll
            for (int qq = 0; qq < NQ; ++qq) SC[qq * SCP + key] = s[qq];
        }
        __syncthreads();
        { LAS float* row = SC + wid * SCP;
            float mx = -INFINITY; for (int key = lane; key < 1040; key += 64) mx = fmaxf(mx, row[key]);
            mx = wave_max(mx);
            float sm = 0.f; for (int key = lane; key < 1040; key += 64) { const float p = exp2f(row[key] - mx); row[key] = p; sm += p; }
            sm = wave_sum(sm); const float inv = 1.0f / sm;
            for (int key = lane; key < 1040; key += 64) row[key] *= inv; }
        __syncthreads();
        { const int e = tid & 127, kq = wid >> 1; float acc[NQ];
#pragma unroll
          for (int qq = 0; qq < NQ; ++qq) acc[qq] = 0.f;
          for (int key = kq * 256; key < kq * 256 + 256; key += 16) {
              float v[16];
#pragma unroll
              for (int u = 0; u < 16; ++u) v[u] = cv[(((size_t)b * 1024 + key + u) * 8 + h) * 128 + e];
#pragma unroll
              for (int qq = 0; qq < NQ; ++qq) {
#pragma unroll
                  for (int u4 = 0; u4 < 4; ++u4) { const f32x4 p4 = *(const LAS f32x4*)(SC + qq * SCP + key + 4 * u4); acc[qq] += (p4.x * v[4 * u4] + p4.y * v[4 * u4 + 1]) + (p4.z * v[4 * u4 + 2] + p4.w * v[4 * u4 + 3]); } } }
          { const int key = 1024 + 4 * kq; float v[4];
#pragma unroll
              for (int u = 0; u < 4; ++u) v[u] = bf2f(Vb[(srow + (key + u - 1024)) * DM + h * 128 + e]);
#pragma unroll
              for (int qq = 0; qq < NQ; ++qq) { const f32x4 p4 = *(const LAS f32x4*)(SC + qq * SCP + key); acc[qq] += (p4.x * v[0] + p4.y * v[1]) + (p4.z * v[2] + p4.w * v[3]); } }
#pragma unroll
          for (int qq = 0; qq < NQ; ++qq) OA[(kq * NQ + qq) * 128 + e] = acc[qq]; }
        __syncthreads();
        { const int qq = wid, e0 = lane * 2; float v[2];
#pragma unroll
          for (int j = 0; j < 2; ++j) v[j] = (OA[(0 * NQ + qq) * 128 + e0 + j] + OA[(1 * NQ + qq) * 128 + e0 + j]) + (OA[(2 * NQ + qq) * 128 + e0 + j] + OA[(3 * NQ + qq) * 128 + e0 + j]);
          if (c == 0) { O0[qq * 128 + e0] = v[0]; O0[qq * 128 + e0 + 1] = v[1]; }
          else { const float o0 = O0[qq * 128 + e0] - lam * v[0], o1 = O0[qq * 128 + e0 + 1] - lam * v[1];
              const float s = wave_sum(o0 * o0 + o1 * o1);
              const float r = rsqrtf(s * (1.f / 128.f) + EPS) * (1.0f - LAM_INIT);
              *(unsigned*)(OC + (srow + q0 + qq) * DM + h * 128 + e0) = pk2(o0 * r * subg[e0], o1 * r * subg[e0 + 1]); } }
        __syncthreads();
    }
}
}

__global__ void __launch_bounds__(NWAVES * 64, 2) yoco_fwd(Args args) {
    extern __shared__ __attribute__((aligned(16))) unsigned char lds[];
    cg::grid_group grid = cg::this_grid();
#define GRID_SYNC() do { asm volatile("s_waitcnt vmcnt(0) lgkmcnt(0)" ::: "memory"); __syncthreads(); \
        if (threadIdx.x == 0) { __builtin_amdgcn_fence(__ATOMIC_RELEASE, "agent"); asm volatile("s_waitcnt vmcnt(0)" ::: "memory"); \
            __hip_atomic_fetch_add(bar_ctr, 1u, __ATOMIC_RELAXED, __HIP_MEMORY_SCOPE_AGENT); bar_target += gridDim.x; \
            while (__hip_atomic_load(bar_ctr, __ATOMIC_RELAXED, __HIP_MEMORY_SCOPE_AGENT) < bar_target) __builtin_amdgcn_s_sleep(8); \
            __builtin_amdgcn_fence(__ATOMIC_ACQUIRE, "agent"); asm volatile("s_waitcnt vmcnt(0)" ::: "memory"); } \
        __syncthreads(); } while (0)
    unsigned* bar_ctr = (unsigned*)args.ws; unsigned bar_target = 0;
    grid.sync();
    Frame F;
    F.lds = (LAS unsigned char*)lds;
#define REFRESH() do { int t_ = threadIdx.x; asm volatile("" : "+v"(t_)); F.tid = t_; F.lane = t_ & 63; F.wave = __builtin_amdgcn_readfirstlane(t_ >> 6); } while (0)
    REFRESH();
    F.G = gridDim.x; { const int bx = blockIdx.x; F.vcu = (F.G % 8 == 0) ? (bx % 8) * (F.G / 8) + bx / 8 : bx; }
    unsigned char* ws = args.ws; float* out = args.out;
    const float* x_prompt = args.in[0]; const float* x_sample = args.in[1]; const float* cache_k = args.in[2]; const float* cache_v = args.in[3]; const float* state_hgrn = args.in[4];
    const float* norm_g = args.in[5]; const float* w_hgrn_in = args.in[6]; const float* lb_logits = args.in[7]; const float* onorm_g = args.in[8]; const float* w_hgrn_out = args.in[9];
    const float* kv_norm_g = args.in[10]; const float* w_kv = args.in[11]; const float* w_dq = args.in[12]; const float* diff_lambda = args.in[13]; const float* subln_g = args.in[14];
    const float* w_do = args.in[15]; const float* w_up = args.in[16]; const float* w_down = args.in[17];
    float* OML = (float*)(ws + WS_OML);
    bf16* Wt_in = (bf16*)(ws + WS_WIN); bf16* Wt_ho = (bf16*)(ws + WS_WHO); bf16* Wt_up0 = (bf16*)(ws + WS_WUP0); bf16* Wt_dn0 = (bf16*)(ws + WS_WDN0);
    bf16* Wt_qkv = (bf16*)(ws + WS_WQKV); bf16* Wt_do = (bf16*)(ws + WS_WDO); bf16* Wt_up1 = (bf16*)(ws + WS_WUP1); bf16* Wt_dn1 = (bf16*)(ws + WS_WDN1);
    bf16* XN = (bf16*)(ws + WS_XN); bf16* MB = (bf16*)(ws + WS_MB); bf16* R0 = (bf16*)(ws + WS_R0);
    bf16* QB = (bf16*)(ws + WS_Q); bf16* KB = (bf16*)(ws + WS_K); bf16* VB = (bf16*)(ws + WS_V); bf16* O1 = (bf16*)(ws + WS_O1); bf16* O2 = (bf16*)(ws + WS_O2); bf16* OC = QB; float* RS = (float*)(ws + WS_RS); float* PACC = (float*)(ws + WS_PACC);
    const int NGW = F.G * NWAVES;

    {
        const int gw = F.vcu * NWAVES + F.wave;
        LAS float* scr = (LAS float*)(F.lds + RING_OFF + F.wave * 16384);
        constexpr int I_SQ = (DM / 64) * (DM / 32), I_UP = (DM / 64) * (FF / 32), I_DN = (FF / 64) * (DM / 32), I_KV = (DM / 64) * (2 * DM / 32);
        constexpr int NITEMS = I_UP   + I_SQ   + 2 * I_UP + 2 * I_DN + I_SQ   + I_KV + I_SQ  ;
        for (int it = gw; it < NITEMS; it += NGW) {
            int r = it;
            if (r < I_UP) { p0_transpose_item(w_hgrn_in, norm_g + 0 * DM, DM, FF, Wt_in, 0, scr, r, F.lane); continue; } r -= I_UP;
            if (r < I_SQ) { p0_transpose_item(w_hgrn_out, nullptr, DM, DM, Wt_ho, 0, scr, r, F.lane); continue; } r -= I_SQ;
            if (r < I_UP) { p0_transpose_item(w_up, norm_g + 2 * DM, DM, FF, Wt_up0, 0, scr, r, F.lane); continue; } r -= I_UP;
            if (r < I_UP) { p0_transpose_item(w_up + (size_t)DM * FF, norm_g + 6 * DM, DM, FF, Wt_up1, 0, scr, r, F.lane); continue; } r -= I_UP;
            if (r < I_DN) { p0_transpose_item(w_down, nullptr, FF, DM, Wt_dn0, 0, scr, r, F.lane); continue; } r -= I_DN;
            if (r < I_DN) { p0_transpose_item(w_down + (size_t)FF * DM, nullptr, FF, DM, Wt_dn1, 0, scr, r, F.lane); continue; } r -= I_DN;
            if (r < I_SQ) { p0_transpose_item(w_dq, norm_g + 4 * DM, DM, DM, Wt_qkv, 0, scr, r, F.lane); continue; } r -= I_SQ;
            if (r < I_KV) { p0_transpose_item(w_kv, kv_norm_g, DM, 2 * DM, Wt_qkv, DM, scr, r, F.lane); continue; } r -= I_KV;
            p0_transpose_item(w_do, nullptr, DM, DM, Wt_do, 0, scr, r, F.lane);
        }
        if (blockIdx.x == 0) { for (int c = F.tid; c < DM; c += NWAVES * 64) { const float l0 = lb_logits[c], l1 = lb_logits[DM + c]; OML[c] = 1.0f / (1.0f + __expf(l0 - l1)); } }
        for (int m = gw; m < M; m += NGW) rms_row_to_bf16(m < NP ? x_prompt + (size_t)m * DM : x_sample + (size_t)(m - NP) * DM, XN + (size_t)m * DM, RS + m, F.lane);
    }
    GRID_SYNC(); if (STOP_AFTER == 0) return;

    {
        pg8::Gemm g{XN, Wt_in, M, FF, DM}; pg8::StaticOrder S; S.init(M, FF, F.G, (int)blockIdx.x);
        pg8::EpiAct<2> E{R0, FF, OML, nullptr, nullptr, 0, 1.f};
        pg8::gemm_phase<pg8::EpiAct<2>, pg8::StaticOrder, PG8_ALIGN, PG8_SP2>(F.lds + RING_OFF, g, S, E);
    }
    GRID_SYNC(); if (STOP_AFTER == 1) { REFRESH(); for (int row = F.vcu * NWAVES + F.wave; row < NP; row += NGW) for (int c = F.lane; c < DM; c += 64) { out[(size_t)row * DM + c] = bf2f(R0[(size_t)row * FF + c]); out[O_KP + (size_t)row * DM + c] = bf2f(R0[(size_t)row * FF + 3072 + c]); } return; }

    for (int it = blockIdx.x; it < 64 + 128; it += F.G) {
        if (it < 64) { const int b = it >> 3, h = it & 7;
            hg::hgrn_item<64>(F.lds + RING_OFF, R0, O2, nullptr, out + O_STP + (size_t)it * 16384, (long)b * 8192, 128, h, onorm_g); }
        else { const int is = it - 64, b = is >> 3, h = is & 7;
            hg::hgrn_item<16>(F.lds + RING_OFF, R0, O2, state_hgrn + (size_t)is * 16384, out + O_STS + (size_t)is * 16384, (long)NP + b * 16, 1, h, onorm_g); }
    }
    GRID_SYNC(); if (STOP_AFTER == 2) { REFRESH(); for (int row = F.vcu * NWAVES + F.wave; row < M; row += NGW) for (int c = F.lane; c < DM; c += 64) out[(size_t)row * DM + c] = bf2f(XN[(size_t)row * DM + c]) - bf2f(MB[(size_t)row * DM + c]);
        for (size_t i = (size_t)blockIdx.x * 512 + F.tid; i < (size_t)192 * 16384; i += (size_t)F.G * 512) { const float a = (i < (size_t)64 * 16384) ? out[O_STP + i] : out[O_STS + i - (size_t)64 * 16384]; out[(size_t)1024 * DM + i] = a - ((const float*)(ws + 900 * MiB))[i]; }
        return; }

    {
        pg8::Gemm g{O2, Wt_ho, M, DM, DM}; pg8::StaticOrder S; S.init(M, DM, F.G, (int)blockIdx.x, DM, SPLK);
        pg8::EpiAct<0> E{MB, DM, nullptr, nullptr, nullptr, 0, 1.f, PACC};
        pg8::gemm_phase<pg8::EpiAct<0>, pg8::StaticOrder, PG8_ALIGN, PG8_SP2>(F.lds + RING_OFF, g, S, E);
    }
    GRID_SYNC(); if (STOP_AFTER == 3) { REFRESH(); for (int row = F.vcu * NWAVES + F.wave; row < M; row += NGW) for (int c = F.lane; c < DM; c += 64) out[(size_t)row * DM + c] = bf2f(MB[(size_t)row * DM + c]); return; }
    REFRESH(); norm_phase<false>(F, MB, PACC, norm_g + 1 * DM, RS, out, XN);
    GRID_SYNC(); if (STOP_AFTER == 4) return;
    {
        pg8::Gemm g{XN, Wt_up0, M, FF, DM}; pg8::StaticOrder S; S.init(M, FF, F.G, (int)blockIdx.x);
        pg8::EpiAct<1> E{R0, FF, nullptr, nullptr, nullptr, 0, 1.f};
        pg8::gemm_phase<pg8::EpiAct<1>, pg8::StaticOrder, PG8_ALIGN, PG8_SP2>(F.lds + RING_OFF, g, S, E);
    }
    GRID_SYNC(); if (STOP_AFTER == 5) return;
    {
        pg8::Gemm g{R0, Wt_dn0, M, DM, FF}; pg8::StaticOrder S; S.init(M, DM, F.G, (int)blockIdx.x, FF, SPLK);
        pg8::EpiAct<0> E{MB, DM, nullptr, nullptr, nullptr, 0, 1.f, PACC};
        pg8::gemm_phase<pg8::EpiAct<0>, pg8::StaticOrder, PG8_ALIGN, PG8_SP2>(F.lds + RING_OFF, g, S, E);
    }
    GRID_SYNC(); if (STOP_AFTER == 6) return;
    REFRESH(); norm_phase<false>(F, MB, PACC, norm_g + 3 * DM, RS, out, XN);
    GRID_SYNC(); if (STOP_AFTER == 7) return;
    {
        pg8::Gemm g{XN, Wt_qkv, M, 3 * DM, DM}; pg8::StaticOrder S; S.init(M, 3 * DM, F.G, (int)blockIdx.x);
        pg8::EpiAct<3> E{QB, DM, nullptr, out + O_KP, out + O_KS, (size_t)(WS_K - WS_Q) / 2, attn_body::C2};
        pg8::gemm_phase<pg8::EpiAct<3>, pg8::StaticOrder, PG8_ALIGN, PG8_SP2>(F.lds + RING_OFF, g, S, E);
    }
    GRID_SYNC(); if (STOP_AFTER == 8) return;
    {
        const attn_body::AttnTensors AT{(const attn_body::bf16*)QB, (const attn_body::bf16*)KB, (const attn_body::bf16*)VB, (attn_body::bf16*)O1, (attn_body::bf16*)O2};
        const attn_body::StaticOrder S((int)F.G, (int)blockIdx.x);
        attn_body::attn_phase<attn_body::StaticOrder>((char*)lds + RING_OFF, AT, S);
        asm volatile("s_waitcnt vmcnt(0) lgkmcnt(0)" ::: "memory"); __syncthreads();
        REFRESH(); const float lam = compute_lam(diff_lambda, F.lane);
        for (int it = F.vcu; it < 256; it += F.G) sa::item(F.lds + RING_OFF, it, QB, KB, VB, cache_k, cache_v, OC, lam, subln_g);
    }
    GRID_SYNC(); if (STOP_AFTER == 9) return;
    REFRESH(); combine_phase(F, O1, O2, diff_lambda, subln_g, OC);
    GRID_SYNC(); if (STOP_AFTER == 10) return;
    {
        pg8::Gemm g{OC, Wt_do, M, DM, DM}; pg8::StaticOrder S; S.init(M, DM, F.G, (int)blockIdx.x, DM, SPLK);
        pg8::EpiAct<0> E{MB, DM, nullptr, nullptr, nullptr, 0, 1.f, PACC};
        pg8::gemm_phase<pg8::EpiAct<0>, pg8::StaticOrder, PG8_ALIGN, PG8_SP2>(F.lds + RING_OFF, g, S, E);
    }
    GRID_SYNC(); if (STOP_AFTER == 11) return;
    REFRESH(); norm_phase<false>(F, MB, PACC, norm_g + 5 * DM, RS, out, XN);
    GRID_SYNC(); if (STOP_AFTER == 12) return;
    {
        pg8::Gemm g{XN, Wt_up1, M, FF, DM}; pg8::StaticOrder S; S.init(M, FF, F.G, (int)blockIdx.x);
        pg8::EpiAct<1> E{R0, FF, nullptr, nullptr, nullptr, 0, 1.f};
        pg8::gemm_phase<pg8::EpiAct<1>, pg8::StaticOrder, PG8_ALIGN, PG8_SP2>(F.lds + RING_OFF, g, S, E);
    }
    GRID_SYNC(); if (STOP_AFTER == 13) return;
    {
        pg8::Gemm g{R0, Wt_dn1, M, DM, FF}; pg8::StaticOrder S; S.init(M, DM, F.G, (int)blockIdx.x, FF, SPLK);
        pg8::EpiAct<0> E{MB, DM, nullptr, nullptr, nullptr, 0, 1.f, PACC};
        pg8::gemm_phase<pg8::EpiAct<0>, pg8::StaticOrder, PG8_ALIGN, PG8_SP2>(F.lds + RING_OFF, g, S, E);
    }
    GRID_SYNC(); if (STOP_AFTER == 14) return;
    REFRESH(); norm_phase<true>(F, MB, PACC, norm_g + 7 * DM, RS, out, XN);
}

extern "C" void kernel_launch(void* const* d_in, const int* in_sizes, int n_in, void* d_out, int out_size, void* d_ws, size_t ws_size, hipStream_t stream) {
    static int grid = 0;
    if (grid == 0) {
        if (n_in != 18 || in_sizes[0] != NP * DM || (size_t)out_size != O_END || ws_size < WS_END) {
            fprintf(stderr, "kernel_launch: shape mismatch: n_in %d in0 %d out %d ws %zu (need out %zu ws %zu); nothing launched\n", n_in, n_in > 0 ? in_sizes[0] : -1, out_size, ws_size, (size_t)O_END, (size_t)WS_END); grid = -1; return; }
        int dev = 0, cus = 0, per_cu = 0;
        if (hipGetDevice(&dev) != hipSuccess || hipDeviceGetAttribute(&cus, hipDeviceAttributeMultiprocessorCount, dev) != hipSuccess) { fprintf(stderr, "kernel_launch: device query failed\n"); grid = -1; return; }
        if (hipFuncSetAttribute((const void*)yoco_fwd, hipFuncAttributeMaxDynamicSharedMemorySize, LDS_BYTES) != hipSuccess) { fprintf(stderr, "kernel_launch: hipFuncSetAttribute failed\n"); grid = -1; return; }
        if (hipOccupancyMaxActiveBlocksPerMultiprocessor(&per_cu, (const void*)yoco_fwd, NWAVES * 64, LDS_BYTES) != hipSuccess || per_cu < 1) { fprintf(stderr, "kernel_launch: occupancy query says %d\n", per_cu); per_cu = 1; }
        (void)hipGetLastError();
        grid = cus;
    }
    if (grid < 0) return;
    if (hipMemsetAsync(d_ws, 0, 256, stream) != hipSuccess) { fprintf(stderr, "kernel_launch: memset failed\n"); return; }
    Args a{};
    for (int i = 0; i < 18; ++i) a.in[i] = (const float*)d_in[i];
    a.out = (float*)d_out; a.ws = (unsigned char*)d_ws;
    void* kargs[] = {&a};
    hipError_t e = hipLaunchCooperativeKernel((const void*)yoco_fwd, dim3(grid), dim3(NWAVES * 64), kargs, LDS_BYTES, stream);
    if (e != hipSuccess) fprintf(stderr, "kernel_launch: cooperative launch failed: %s (grid %d)\n", hipGetErrorString(e), grid);
}
```

```cpp
#include <hip/hip_runtime.h>
#include <cstdio>
#include <cstdint>
namespace pg8 {
#define PG8_LAS __attribute__((address_space(3)))
typedef unsigned short bf16_t;
typedef short bf16x8 __attribute__((ext_vector_type(8)));
typedef float f32x4 __attribute__((ext_vector_type(4)));
typedef unsigned u32x4 __attribute__((ext_vector_type(4)));
constexpr int BM = 256, BK = 64, HALF = 128, HTB = HALF * BK * 2  , STAGE_BYTES = 8 * HTB, NXCD = 8, WGM = 8;

__host__ __device__ __forceinline__ int lds_byte(int r, int c) { const int st = (r >> 4) * 2 + (c >> 5), rr = r & 15, cc = c & 31, ob = rr * 64 + cc * 2; return st * 1024 + (ob ^ (((ob >> 9) & 1) << 5)); }
__host__ __device__ __forceinline__ void stage_rc(int b, int& R, int& C) { const int st = b / 1024, sb = b % 1024, swz = sb ^ (((sb >> 9) & 1) << 5); R = (st >> 1) * 16 + swz / 64; C = (st & 1) * 32 + (swz % 64) / 2; }
__host__ __device__ __forceinline__ int perm32(int rho) { const int n = rho >> 4, i = rho & 15; return 8 * (i >> 2) + 4 * n + (i & 3); }

struct Unit { int pm, pn; };
struct Gemm { const bf16_t* A; const bf16_t* Bt; int M, N, K; };

struct StaticOrder {
    int nM, nN, nwg, G, c, spl, nfull, ntk;
    __host__ __device__ __forceinline__ void init(int M, int N, int G_, int c_, int K = 0, int spl_ = 1) { nM = M / BM; nN = N / BM; G = G_; c = c_; spl = spl_; ntk = K / BK;
        if (spl > 1) { nM -= 1; nfull = nM * nN; nwg = nfull + nN * spl; } else { nfull = nwg = nM * nN; } }
    __host__ __device__ __forceinline__ bool next(int i, Unit& u) const {
        const long L = (long)i * G + c; if (L >= nwg) return false;
        if (L >= nfull) { const int j = (int)(L - nfull); u.pm = nM; u.pn = (j % nN) | ((j / nN + 1) << 8); return true; }
        int wgid = (int)L; { const int q = nfull / NXCD, r = nfull % NXCD, xcd = wgid % NXCD, off = wgid / NXCD; wgid = (xcd < r ? xcd * (q + 1) : r * (q + 1) + (xcd - r) * q) + off; }
        const int nig = WGM * nN, gid = wgid / nig, fm = gid * WGM, gsz = (nM - fm) < WGM ? (nM - fm) : WGM;
        u.pm = fm + ((wgid % nig) % gsz); u.pn = (wgid % nig) / gsz; return true;
    }
    __device__ __forceinline__ void a_ready(const Unit&) const {}
    __device__ __forceinline__ void done(const Unit&) const {}
};
typedef float cvt_f32x2_t __attribute__((ext_vector_type(2))); typedef __bf16 cvt_bf16x2_t __attribute__((ext_vector_type(2)));
__device__ __forceinline__ unsigned cvt_pk_bf16(float lo, float hi) { cvt_f32x2_t v = {lo, hi}; cvt_bf16x2_t b = __builtin_convertvector(v, cvt_bf16x2_t); return __builtin_bit_cast(unsigned, b); }
typedef float f32x2 __attribute__((ext_vector_type(2)));

typedef unsigned u32x4 __attribute__((ext_vector_type(4)));
__device__ __forceinline__ float fast_rcp(float x) { return __builtin_amdgcn_rcpf(x); }
__device__ __forceinline__ float silu_f(float x) { return x * fast_rcp(1.0f + __expf(-x)); }
template <int MODE> struct EpiAct {
    static constexpr bool PERM = true, AFTER_DRAIN = false;
    bf16_t* O; int ldc; const float* aux; float* kvp; float* kvs; size_t split_stride; float scale0; float* pacc = nullptr;
    __device__ __forceinline__ void operator()(const f32x4 (&acc)[2][2][4][2], const Unit& u, int wr, int wc, int fr, int fq) const {
        const int row0 = u.pm * BM + wr * 64 + fr;
        const int upn = u.pn & 255, upart = u.pn >> 8; int colt = upn * BM; bf16_t* base = O; float* fbase = nullptr; int type = 0;
        if (MODE == 2) type = upn >> 2;
        if (MODE == 3) { type = upn >> 2; colt -= type * 1024; base = O + (size_t)type * split_stride;
            if (type > 0) { fbase = (u.pm < 256) ? kvp + (size_t)(type - 1) * (65536u * 1024u) : (kvs + (size_t)(type - 1) * (256u * 1024u)) - (size_t)65536 * 1024; } }
        const int col0 = colt + wc * 32 + 8 * fq;
        f32x4 av[2][2];
        if (MODE == 2) {
#pragma unroll
            for (int bj = 0; bj < 2; ++bj)
#pragma unroll
                for (int n = 0; n < 2; ++n) av[bj][n] = (type == 1) ? *(const f32x4*)(aux + ((col0 + bj * HALF + 4 * n) & 1023)) : (f32x4){0.f, 0.f, 0.f, 0.f};
        }
#pragma unroll
        for (int ai = 0; ai < 2; ++ai)
#pragma unroll
            for (int m = 0; m < 4; ++m) { const size_t roff = (size_t)(row0 + ai * HALF + m * 16) * ldc + col0; bf16_t* rowp = base + roff;
#pragma unroll
                for (int bj = 0; bj < 2; ++bj) { f32x4 v0 = acc[ai][bj][m][0], v1 = acc[ai][bj][m][1];
                    if (MODE == 0 && upart != 0) { float* fp = pacc + (size_t)(upart - 1) * (256u * 1024u) + (size_t)(wr * 64 + fr + ai * HALF + m * 16) * ldc + col0 + bj * HALF; *(f32x4*)fp = v0; *(f32x4*)(fp + 4) = v1; continue; }
                    if (MODE == 1) {
#pragma unroll
                        for (int e = 0; e < 4; ++e) { const float a = fmaxf(v0[e], 0.f), b = fmaxf(v1[e], 0.f); v0[e] = a * a; v1[e] = b * b; } }
                    if (MODE == 2) {
                        if (type == 0 || type == 3) {
#pragma unroll
                            for (int e = 0; e < 4; ++e) { v0[e] = silu_f(v0[e]); v1[e] = silu_f(v1[e]); } }
                        else if (type == 1) {
#pragma unroll
                            for (int e = 0; e < 4; ++e) { v0[e] = av[bj][0][e] * fast_rcp(1.0f + __expf(v0[e])); v1[e] = av[bj][1][e] * fast_rcp(1.0f + __expf(v1[e])); } }
                    }
                    if (MODE == 3) {
                        if (type == 0) { v0 = v0 * scale0; v1 = v1 * scale0; }
                        else { float* fp = fbase + roff + bj * HALF; *(f32x4*)fp = v0; *(f32x4*)(fp + 4) = v1; }
                    }
                    u32x4 w; w.x = cvt_pk_bf16(v0[0], v0[1]); w.y = cvt_pk_bf16(v0[2], v0[3]); w.z = cvt_pk_bf16(v1[0], v1[1]); w.w = cvt_pk_bf16(v1[2], v1[3]);
                    *(u32x4*)(rowp + bj * HALF) = w; } }
    }
};

template <class Epi, class Sched, bool ALIGN_EPI = false, bool SP2 = false>
__device__ __forceinline__ void gemm_phase(PG8_LAS unsigned char* lds, const Gemm g, const Sched& S, const Epi& E) {
    int tid_ = threadIdx.x; asm volatile("" : "+v"(tid_));
    const int tid = tid_, wid = __builtin_amdgcn_readfirstlane(tid >> 6), lane = tid & 63, wr = wid >> 2, wc = wid & 3, fr = lane & 15, fq = lane >> 4;
    const int K = g.K, nt = K / BK;
    unsigned voffA[2], voffB[2];
#pragma unroll
    for (int i = 0; i < 2; ++i) { int R, C; stage_rc(tid * 16 + i * 8192, R, C); const int Rb = Epi::PERM ? ((R & ~31) + perm32(R & 31)) : R;
        voffA[i] = (unsigned)(R * K + C) * 2u; voffB[i] = (unsigned)(Rb * K + C) * 2u; }
    const size_t kstep = (size_t)(BK * 2);
    const size_t hstep = (size_t)HALF * K * 2;
    const size_t tstep = 2 * hstep;
    const unsigned ldsw = (unsigned)wid * 1024u;
    const int aoff = lds_byte(wr * 64 + fr, fq * 8), boff = lds_byte(wc * 32 + fr, fq * 8);
#define PG8_SA(b, h) (((b) * 2 + (h)) * HTB)
#define PG8_SB(b, h) ((4 + (b) * 2 + (h)) * HTB)
#define PG8_STAGE(bufoff, gbase, voff) do { _Pragma("unroll") for (int _i = 0; _i < 2; ++_i) \
        __builtin_amdgcn_global_load_lds((const unsigned*)((const char*)(gbase) + (voff)[_i]), (PG8_LAS unsigned*)(lds + (bufoff) + ldsw + _i * 8192), 16, 0, 0); } while (0)
#define PG8_LDA(dst, b, h) do { _Pragma("unroll") for (int m = 0; m < 4; ++m) _Pragma("unroll") for (int k = 0; k < 2; ++k) dst[m][k] = *(const PG8_LAS bf16x8*)(lds + PG8_SA(b, h) + aoff + m * 2048 + k * 1024); } while (0)
#define PG8_LDB(dst, b, h) do { _Pragma("unroll") for (int n = 0; n < 2; ++n) _Pragma("unroll") for (int k = 0; k < 2; ++k) dst[n][k] = *(const PG8_LAS bf16x8*)(lds + PG8_SB(b, h) + boff + n * 2048 + k * 1024); } while (0)
#define PG8_MMA(ai, bj, At, Bt) do { __builtin_amdgcn_s_setprio(1); _Pragma("unroll") for (int m = 0; m < 4; ++m) _Pragma("unroll") for (int n = 0; n < 2; ++n) _Pragma("unroll") for (int k = 0; k < 2; ++k) \
        acc[ai][bj][m][n] = __builtin_amdgcn_mfma_f32_16x16x32_bf16(Bt[n][k], At[m][k], acc[ai][bj][m][n], 0, 0, 0); __builtin_amdgcn_s_setprio(0); } while (0)
#define PG8_WAIT_V(n) asm volatile("s_waitcnt vmcnt(" #n ")" ::: "memory")
#define PG8_WAIT_L(n) asm volatile("s_waitcnt lgkmcnt(" #n ")" ::: "memory")
#define PG8_BAR __builtin_amdgcn_s_barrier()
#define PG8_SCHED __builtin_amdgcn_sched_barrier(0)
    Unit cur, nxt; int ui = 0;
    if (!S.next(0, cur)) return;
    const int nktp = S.spl > 1 ? S.ntk / S.spl : nt;
#define PG8_NT(u) (((u).pn >> 8) ? nktp : nt)
#define PG8_K0(u) ((size_t)(((u).pn >> 8) ? (((u).pn >> 8) - 1) * nktp : 0) * kstep)
    int ntc = PG8_NT(cur);
    f32x4 acc[2][2][4][2];
#pragma unroll
    for (int a = 0; a < 2; ++a)
#pragma unroll
        for (int b = 0; b < 2; ++b)
#pragma unroll
            for (int m = 0; m < 4; ++m)
#pragma unroll
                for (int n = 0; n < 2; ++n) acc[a][b][m][n] = (f32x4){0.f, 0.f, 0.f, 0.f};
    bf16x8 At[4][2], B0[2][2], B1[2][2];
    const char* cA = (const char*)g.A + (size_t)cur.pm * tstep + PG8_K0(cur); const char* cB = (const char*)g.Bt + (size_t)(cur.pn & 255) * tstep + PG8_K0(cur);
    S.a_ready(cur);
    if constexpr (SP2) {
        PG8_STAGE(PG8_SB(0, 0), cB, voffB); PG8_STAGE(PG8_SB(0, 1), cB + hstep, voffB); PG8_STAGE(PG8_SA(0, 0), cA, voffA); PG8_STAGE(PG8_SA(0, 1), cA + hstep, voffA);
        if (wr == 1) PG8_BAR;
        PG8_WAIT_V(2); PG8_BAR;
        PG8_STAGE(PG8_SB(1, 0), cB + kstep, voffB); PG8_STAGE(PG8_SA(1, 0), cA + kstep, voffA); PG8_STAGE(PG8_SB(1, 1), cB + hstep + kstep, voffB);
        PG8_WAIT_V(6); PG8_BAR;
    } else {
        PG8_STAGE(PG8_SB(0, 0), cB, voffB); PG8_STAGE(PG8_SA(0, 0), cA, voffA); PG8_STAGE(PG8_SB(0, 1), cB + hstep, voffB); PG8_STAGE(PG8_SA(0, 1), cA + hstep, voffA);
        if (wr == 1) PG8_BAR;
        PG8_WAIT_V(4); PG8_BAR;
        PG8_STAGE(PG8_SB(1, 0), cB + kstep, voffB); PG8_STAGE(PG8_SA(1, 0), cA + kstep, voffA); PG8_STAGE(PG8_SB(1, 1), cB + hstep + kstep, voffB);
        PG8_WAIT_V(6); PG8_BAR;
    }
    for (;;) {
        const bool has_next = S.next(ui + 1, nxt);
        const char* nA = has_next ? (const char*)g.A + (size_t)nxt.pm * tstep + PG8_K0(nxt) : cA; const char* nB = has_next ? (const char*)g.Bt + (size_t)(nxt.pn & 255) * tstep + PG8_K0(nxt) : cB;
        for (int t = 0; t < ntc; t += 2) {
            const bool last = (t == ntc - 2);
            const char* a1 = cA + (size_t)(t + 1) * kstep;
            const char* a2 = last ? nA : cA + (size_t)(t + 2) * kstep; const char* b2 = last ? nB : cB + (size_t)(t + 2) * kstep;
            const char* a3 = a2 + kstep; const char* b3 = b2 + kstep;
            if (last && has_next) S.a_ready(nxt);
            if constexpr (SP2) {
            PG8_LDB(B0, 0, 0); PG8_LDB(B1, 0, 1); PG8_SCHED; PG8_LDA(At, 0, 0); PG8_STAGE(PG8_SA(1, 1), a1 + hstep, voffA);
            PG8_WAIT_V(8); PG8_WAIT_L(0); PG8_BAR; PG8_MMA(0, 0, At, B0); PG8_MMA(0, 1, At, B1); PG8_BAR; PG8_SCHED;
            PG8_LDA(At, 0, 1); PG8_STAGE(PG8_SB(0, 0), b2, voffB); PG8_STAGE(PG8_SB(0, 1), b2 + hstep, voffB); PG8_STAGE(PG8_SA(0, 0), a2, voffA);
            PG8_WAIT_V(8); PG8_WAIT_L(0); PG8_BAR; PG8_MMA(1, 0, At, B0); PG8_MMA(1, 1, At, B1); PG8_BAR; PG8_SCHED;
            PG8_LDB(B0, 1, 0); PG8_LDB(B1, 1, 1); PG8_SCHED; PG8_LDA(At, 1, 0); PG8_STAGE(PG8_SA(0, 1), a2 + hstep, voffA);
            PG8_WAIT_V(8); PG8_WAIT_L(0); PG8_BAR; PG8_MMA(0, 0, At, B0); PG8_MMA(0, 1, At, B1); PG8_BAR; PG8_SCHED;
            PG8_LDA(At, 1, 1); PG8_STAGE(PG8_SB(1, 0), b3, voffB); PG8_STAGE(PG8_SB(1, 1), b3 + hstep, voffB); PG8_STAGE(PG8_SA(1, 0), a3, voffA);
            PG8_WAIT_V(8); PG8_WAIT_L(0); PG8_BAR; PG8_MMA(1, 0, At, B0); PG8_MMA(1, 1, At, B1); PG8_BAR; PG8_SCHED;
            } else {
            PG8_LDB(B0, 0, 0); PG8_SCHED; PG8_LDA(At, 0, 0); PG8_STAGE(PG8_SA(1, 1), a1 + hstep, voffA);
            PG8_WAIT_L(8); PG8_BAR; PG8_WAIT_L(0); PG8_MMA(0, 0, At, B0); PG8_BAR; PG8_SCHED;
            PG8_LDB(B1, 0, 1); PG8_STAGE(PG8_SB(0, 0), b2, voffB);
            PG8_BAR; PG8_WAIT_L(0); PG8_MMA(0, 1, At, B1); PG8_BAR;
            PG8_LDA(At, 0, 1); PG8_STAGE(PG8_SA(0, 0), a2, voffA);
            PG8_BAR; PG8_WAIT_L(0); PG8_MMA(1, 0, At, B0); PG8_BAR; PG8_SCHED;
            PG8_STAGE(PG8_SB(0, 1), b2 + hstep, voffB);
            PG8_WAIT_V(6); PG8_BAR; PG8_MMA(1, 1, At, B1); PG8_BAR;
            PG8_LDB(B0, 1, 0); PG8_SCHED; PG8_LDA(At, 1, 0); PG8_STAGE(PG8_SA(0, 1), a2 + hstep, voffA);
            PG8_WAIT_L(8); PG8_BAR; PG8_WAIT_L(0); PG8_MMA(0, 0, At, B0); PG8_BAR; PG8_SCHED;
            PG8_LDB(B1, 1, 1); PG8_STAGE(PG8_SB(1, 0), b3, voffB);
            PG8_BAR; PG8_WAIT_L(0); PG8_MMA(0, 1, At, B1); PG8_BAR;
            PG8_LDA(At, 1, 1); PG8_STAGE(PG8_SA(1, 0), a3, voffA);
            PG8_BAR; PG8_WAIT_L(0); PG8_MMA(1, 0, At, B0); PG8_BAR; PG8_SCHED;
            PG8_STAGE(PG8_SB(1, 1), b3 + hstep, voffB);
            PG8_WAIT_V(6); PG8_BAR; PG8_MMA(1, 1, At, B1); PG8_BAR;
            }
        }
        if constexpr (ALIGN_EPI) { if (wr == 0) PG8_BAR; }
        if constexpr (!Epi::AFTER_DRAIN) { E(acc, cur, wr, wc, fr, fq); S.done(cur); }
        if (!has_next) break;
#pragma unroll
        for (int a = 0; a < 2; ++a)
#pragma unroll
            for (int b = 0; b < 2; ++b)
#pragma unroll
                for (int m = 0; m < 4; ++m)
#pragma unroll
                    for (int n = 0; n < 2; ++n) acc[a][b][m][n] = (f32x4){0.f, 0.f, 0.f, 0.f};
        cur = nxt; cA = nA; cB = nB; ++ui; ntc = PG8_NT(cur);
        if constexpr (ALIGN_EPI) { if (wr == 1) PG8_BAR; }
    }
    PG8_WAIT_V(0);
    if constexpr (!ALIGN_EPI) { if (wr == 0) PG8_BAR; }
    PG8_BAR;
    if constexpr (Epi::AFTER_DRAIN) { E.fused(acc, cur, wr, wc, fr, fq, lds, wid, lane); S.done(cur); }
#undef PG8_SA
#undef PG8_SB
#undef PG8_STAGE
#undef PG8_LDA
#undef PG8_LDB
#undef PG8_MMA
#undef PG8_WAIT_V
#undef PG8_WAIT_L
#undef PG8_BAR
#undef PG8_SCHED
#undef PG8_NT
#undef PG8_K0
}
}
#define PG8_SP2 true
#define PG8_ALIGN true
#include <hip/hip_bf16.h>
#include <cmath>
namespace attn_body {
using bf16=__hip_bfloat16;
using bf16x8=__attribute__((ext_vector_type(8)))short;
using s16x4=__attribute__((ext_vector_type(4)))short;
using f32x16=__attribute__((ext_vector_type(16)))float;
using u32x4=__attribute__((ext_vector_type(4)))unsigned;
constexpr int BATCH=8,NHEAD=16,SEQ=8192,D=64,DM=NHEAD*D;
constexpr int NW=8,QBLK=32,QB=QBLK*NW,KVBLK=64,NQB=SEQ/QB;
constexpr int ATTN_PITCH=DM, ATTN_UNIT_ROWS=QB;
__device__ __forceinline__ int crow(int r,int hi){return (r&3)+8*(r>>2)+4*hi;}
#define SBAR() __builtin_amdgcn_sched_barrier(0)
__device__ __forceinline__ void cmask(f32x16&p0,f32x16&p1,int jb,int qrel,int hi){
  const float NEG=-INFINITY; (void)hi;
  if(jb>(qrel>>6)){
  #pragma unroll
  for(int r=0;r<16;++r){p0[r]=NEG;p1[r]=NEG;} }
}

constexpr int NSLOT=3, SLOTB=8192;
constexpr int LDS_K=0, LDS_V=NSLOT*SLOTB, LDS_WS=2*NSLOT*SLOTB, LDS_OST=LDS_WS+NW*64*4, LDS_BYTES=LDS_OST+NW*4096;
constexpr float C2=0.125f*1.4426950408889634f;
__device__ __forceinline__ void glds16(const void*gsrc,unsigned lds_dst){unsigned keep;
  asm volatile("s_mov_b32 %0, m0\n\ts_mov_b32 m0, %2\n\ts_nop 0\n\tglobal_load_lds_dwordx4 %1, off\n\ts_mov_b32 m0, %0":"=&s"(keep):"v"(gsrc),"s"(lds_dst):"memory");}
__device__ __forceinline__ float max3f(float a,float b,float c){float r;asm("v_max3_f32 %0, %1, %2, %3":"=v"(r):"v"(a),"v"(b),"v"(c));return r;}
__device__ __forceinline__ float max2f(float a,float b){float r;asm("v_max_f32_e32 %0, %1, %2":"=v"(r):"v"(a),"v"(b));return r;}
__device__ __forceinline__ float fadd_s(float a,float b){float r;asm("v_add_f32_e32 %0, %1, %2":"=v"(r):"v"(a),"v"(b));return r;}
__device__ __forceinline__ float fsub_s(float a,float b){float r;asm("v_sub_f32_e32 %0, %1, %2":"=v"(r):"v"(a),"v"(b));return r;}
typedef float f32x2_t __attribute__((ext_vector_type(2))); typedef __bf16 bf16x2_t __attribute__((ext_vector_type(2)));
__device__ __forceinline__ unsigned cvtpk_s(float lo,float hi){f32x2_t v={lo,hi};bf16x2_t b=__builtin_convertvector(v,bf16x2_t);return __builtin_bit_cast(unsigned,b);}
#define WAIT_BAR(N) asm volatile("s_waitcnt vmcnt(" #N ") lgkmcnt(0)\n\ts_barrier":::"memory")

__device__ __forceinline__ void qkt(f32x16&p0,f32x16&p1,const char*Kslot,const bf16x8*qr,const f32x16&negm,int r32,int hi){
  const char*kb=Kslot+hi*1024+r32*16;
  #pragma unroll
  for(int d0=0;d0<4;++d0){
    const bf16x8 b0=*reinterpret_cast<const bf16x8*>(kb+d0*2048);
    const bf16x8 b1=*reinterpret_cast<const bf16x8*>(kb+d0*2048+512);
    if(d0==0){p0=__builtin_amdgcn_mfma_f32_32x32x16_bf16(b0,qr[0],negm,0,0,0);p1=__builtin_amdgcn_mfma_f32_32x32x16_bf16(b1,qr[0],negm,0,0,0);}
    else{p0=__builtin_amdgcn_mfma_f32_32x32x16_bf16(b0,qr[d0],p0,0,0,0);p1=__builtin_amdgcn_mfma_f32_32x32x16_bf16(b1,qr[d0],p1,0,0,0);}}
}
typedef __attribute__((address_space(3))) const char* lds_cptr;
typedef short v4i16_t __attribute__((ext_vector_type(4)));
__device__ __forceinline__ void kload8(bf16x8*kf,lds_cptr kp){
  kf[0]=*(const __attribute__((address_space(3))) bf16x8*)(kp);      kf[1]=*(const __attribute__((address_space(3))) bf16x8*)(kp+512);
  kf[2]=*(const __attribute__((address_space(3))) bf16x8*)(kp+2048); kf[3]=*(const __attribute__((address_space(3))) bf16x8*)(kp+2560);
  kf[4]=*(const __attribute__((address_space(3))) bf16x8*)(kp+4096); kf[5]=*(const __attribute__((address_space(3))) bf16x8*)(kp+4608);
  kf[6]=*(const __attribute__((address_space(3))) bf16x8*)(kp+6144); kf[7]=*(const __attribute__((address_space(3))) bf16x8*)(kp+6656);
}
__device__ __forceinline__ void kload2(bf16x8*kf,lds_cptr kp,int j){ kf[2*j]=*(const __attribute__((address_space(3))) bf16x8*)(kp+j*2048); kf[2*j+1]=*(const __attribute__((address_space(3))) bf16x8*)(kp+j*2048+512); }
__device__ __forceinline__ s16x4 vtr(lds_cptr p){ return __builtin_bit_cast(s16x4,__builtin_amdgcn_ds_read_tr16_b64_v4i16((__attribute__((address_space(3))) v4i16_t*)p)); }
__device__ __forceinline__ float rowmax(const f32x16&p0,const f32x16&p1){
  float a=max3f(p0[0],p0[1],p1[0]),b=max3f(p0[2],p0[3],p1[1]);a=max3f(a,p1[2],p1[3]);
  #pragma unroll
  for(int r=4;r<16;r+=4){a=max3f(a,p0[r],p0[r+1]);b=max3f(b,p0[r+2],p0[r+3]);a=max3f(a,p1[r],p1[r+1]);b=max3f(b,p1[r+2],p1[r+3]);}
  const float m=max2f(a,b);
  auto rr=__builtin_amdgcn_permlane32_swap(__float_as_uint(m),__float_as_uint(m),false,false);
  return max2f(__uint_as_float(rr[0]),__uint_as_float(rr[1]));
}
__device__ __forceinline__ void pv(f32x16*o,int vb,bf16x8 pa0,bf16x8 pa1,bf16x8 pa2,bf16x8 pa3){
  #pragma unroll
  for(int d0=0;d0<2;++d0){s16x4 lo[4],hi[4];
    #pragma unroll
    for(int ks=0;ks<4;++ks){
      asm volatile("ds_read_b64_tr_b16 %0,%1 offset:%c2":"=&v"(lo[ks]):"v"(vb),"i"(d0*4096+ks*1024):"memory");
      asm volatile("ds_read_b64_tr_b16 %0,%1 offset:%c2":"=&v"(hi[ks]):"v"(vb),"i"(d0*4096+ks*1024+512):"memory");}
    asm volatile("s_waitcnt lgkmcnt(0)":::"memory");SBAR();
    #define PK(k) (bf16x8){lo[k][0],lo[k][1],lo[k][2],lo[k][3],hi[k][0],hi[k][1],hi[k][2],hi[k][3]}
    o[d0]=__builtin_amdgcn_mfma_f32_32x32x16_bf16(pa0,PK(0),o[d0],0,0,0);
    o[d0]=__builtin_amdgcn_mfma_f32_32x32x16_bf16(pa1,PK(1),o[d0],0,0,0);
    o[d0]=__builtin_amdgcn_mfma_f32_32x32x16_bf16(pa2,PK(2),o[d0],0,0,0);
    o[d0]=__builtin_amdgcn_mfma_f32_32x32x16_bf16(pa3,PK(3),o[d0],0,0,0);
    #undef PK
  }
}

#ifndef ATTN_STORE16
#define ATTN_STORE16(p,v) (*(u32x4*)(p)=(v))
#endif
template<int THRL> __device__ __forceinline__ void attn_unit(int b,int h,int hv,int qb,const bf16*Q,const bf16*__restrict__ K,const bf16*__restrict__ V,bf16*O,char*shm){
  int tid_=threadIdx.x; asm volatile("":"+v"(tid_)); const int tid=tid_,lane=tid&63,r32=lane&31,hi=lane>>5; const int wid=__builtin_amdgcn_readfirstlane(tid>>6);
  const long rowbase=(long)b*SEQ; const int q0=qb*QB;
  const bf16*Qw=Q+(rowbase+q0+wid*QBLK)*DM+h*D;
  const bf16*Kh=K+rowbase*DM+h*D,*Vh=V+rowbase*DM+hv*D;
  const unsigned lds0=(unsigned)(uintptr_t)shm;
  float*wsf=(float*)(shm+LDS_WS)+wid*64;
  const bf16*ksrc=Kh+(long)lane*DM+wid*8;
  const bf16*vsrc=Vh+(long)(16*(wid&3)+(lane>>2))*DM+(wid>>2)*32+(lane&3)*8;
  const unsigned kdst=lds0+LDS_K+wid*1024, vdst=lds0+LDS_V+wid*1024;
  #define DMA_K(t,slot) glds16(ksrc+(long)(t)*KVBLK*DM,(unsigned)__builtin_amdgcn_readfirstlane(kdst+(slot)))
  #define DMA_V(t,slot) glds16(vsrc+(long)(t)*KVBLK*DM,(unsigned)__builtin_amdgcn_readfirstlane(vdst+(slot)))
  const int vb0=(int)(lds0+LDS_V)+((lane>>4)&1)*32+(lane&3)*8+(4*hi+((lane&15)>>2))*64;
  const char*Kbase=shm+LDS_K; bf16x8 kf[8];
  const lds_cptr shm3=(lds_cptr)shm; const lds_cptr kp0=shm3+LDS_K+hi*1024+r32*16; const lds_cptr vp0=shm3+LDS_V+((lane>>4)&1)*32+(lane&3)*8+(4*hi+((lane&15)>>2))*64;
  const int NT=(q0+QB)/KVBLK;
  DMA_K(0,0);DMA_V(0,0);DMA_K(1,SLOTB);
  bf16x8 qr[4];
  #pragma unroll
  for(int d0=0;d0<4;++d0)qr[d0]=*reinterpret_cast<const bf16x8*>(&Qw[(long)r32*DM+d0*16+hi*8]);
  float mhat=0.f,l_reg=0.f;f32x16 o[2];o[0]=f32x16{};o[1]=f32x16{};f32x16 negm=f32x16{};asm volatile("":"+v"(negm));
  const int qrel=wid*QBLK+r32;
  #define CMASK(P0,P1,t) do{int jb_=(t)-(NT-4); if(jb_>=0)cmask(P0,P1,jb_,qrel,hi);}while(0)
  bool resc=false;
  #define START(P0,P1) do{ const float rm=rowmax(P0,P1); resc=false; \
    { const float dl=rm; mhat=fadd_s(mhat,dl); \
      _Pragma("unroll") for(int r=0;r<16;++r){P0[r]=fsub_s(P0[r],dl);P1[r]=fsub_s(P1[r],dl);} \
      _Pragma("unroll") for(int r=0;r<16;++r)negm[r]=-mhat; asm volatile("":"+v"(negm)); } \
    _Pragma("unroll") for(int r=0;r<16;++r)P0[r]=__builtin_amdgcn_exp2f(P0[r]); }while(0)
  #define RESC() do{ if(resc){ asm volatile("s_waitcnt lgkmcnt(0)":::"memory"); \
      _Pragma("unroll") for(int d_=0;d_<2;++d_) _Pragma("unroll") for(int r=0;r<16;++r)o[d_][r]*=wsf[crow(r,hi)]; } }while(0)
  f32x16 pA0,pA1,pB0,pB1;
  int sl_prev=0,sl_cur=0,sl_next=SLOTB;
  #define ROT() do{sl_prev=sl_cur;sl_cur=sl_next;sl_next=(sl_next==(NSLOT-1)*SLOTB)?0:sl_next+SLOTB;}while(0)
  DMA_K(2,2*SLOTB);
  WAIT_BAR(3);
  qkt(pA0,pA1,Kbase,qr,negm,r32,hi);asm volatile("s_nop 15\n\ts_nop 7":"+v"(pA0),"+v"(pA1));CMASK(pA0,pA1,0);
  START(pA0,pA1);
  _Pragma("unroll") for(int r=0;r<16;++r)pA1[r]=__builtin_amdgcn_exp2f(pA1[r]);
  WAIT_BAR(0);
  DMA_K(3,0);DMA_V(1,SLOTB);
  ROT();
  kload8(kf,kp0+sl_cur);
  WAIT_BAR(2);
  s16x4 vlo[8],vhi[8]; u32x4 pw0,pw1,pw2,pw3;
  #define PKW(P,B) cvtpk_s(P[B],P[B+1])
  #define PAF(k) __builtin_bit_cast(bf16x8,pw##k)
  #define VFR(i) (bf16x8){vlo[i][0],vlo[i][1],vlo[i][2],vlo[i][3],vhi[i][0],vhi[i][1],vhi[i][2],vhi[i][3]}
  #define PIN(x) asm volatile("":"+v"(x))
  #define MX3(a,b,c) __builtin_fmaxf(__builtin_fmaxf((a),(b)),(c))
  #define GAPA(MF,A0,A1,A2,A3,W0,W1,PW) do{ MF; sacc+=A0; sacc+=A1; sacc+=A2; sacc+=A3; PIN(sacc); W0; W1; PIN(PW); SBAR(); }while(0)
  #define EX(v) __builtin_amdgcn_exp2f(v)
  #define GAPB(MF,X,B) do{ MF; X[B]=EX(X[B]); X[B+1]=EX(X[B+1]); X[B+2]=EX(X[B+2]); X[B+3]=EX(X[B+3]); PIN(X); SBAR(); }while(0)
  #define VRD(i) do{ vlo[i]=vtr(vp_+(((i)>>2)*4096+((i)&3)*1024)); vhi[i]=vtr(vp_+(((i)>>2)*4096+((i)&3)*1024+512)); }while(0)
  #define KRD(G,j) do{ if(G){ kload2(kf,kp0+sl_next,j); SBAR(); } }while(0)
  #define STEP(C0,C1,P0,P1,t,GK,GV,GL) do{ SBAR(); \
    const lds_cptr vp_=vp0+sl_prev; \
    VRD(0); SBAR(); float sacc=(P0[0]+P0[1]); \
    GAPA(C0=__builtin_amdgcn_mfma_f32_32x32x16_bf16(kf[0],qr[0],negm,0,0,0), P0[2],P0[3],P0[4],P0[5],     pw0[0]=PKW(P0,0), pw0[1]=PKW(P0,2), pw0); \
    VRD(4); SBAR(); GAPA(C1=__builtin_amdgcn_mfma_f32_32x32x16_bf16(kf[1],qr[0],negm,0,0,0), P0[6],P0[7],P0[8],P0[9],     pw0[2]=PKW(P0,4), pw0[3]=PKW(P0,6), pw0); \
    VRD(1); SBAR(); GAPA(C0=__builtin_amdgcn_mfma_f32_32x32x16_bf16(kf[2],qr[1],C0,0,0,0),   P0[10],P0[11],P0[12],P0[13], pw1[0]=PKW(P0,8), pw1[1]=PKW(P0,10), pw1); \
    VRD(5); SBAR(); GAPA(C1=__builtin_amdgcn_mfma_f32_32x32x16_bf16(kf[3],qr[1],C1,0,0,0),   P0[14],P0[15],P1[0],P1[1],   pw1[2]=PKW(P0,12),pw1[3]=PKW(P0,14), pw1); \
    VRD(2); SBAR(); GAPA(C0=__builtin_amdgcn_mfma_f32_32x32x16_bf16(kf[4],qr[2],C0,0,0,0),   P1[2],P1[3],P1[4],P1[5],     pw2[0]=PKW(P1,0), pw2[1]=PKW(P1,2), pw2); \
    VRD(6); SBAR(); GAPA(C1=__builtin_amdgcn_mfma_f32_32x32x16_bf16(kf[5],qr[2],C1,0,0,0),   P1[6],P1[7],P1[8],P1[9],     pw2[2]=PKW(P1,4), pw2[3]=PKW(P1,6), pw2); \
    VRD(3); SBAR(); GAPA(C0=__builtin_amdgcn_mfma_f32_32x32x16_bf16(kf[6],qr[3],C0,0,0,0),   P1[10],P1[11],P1[12],P1[13], pw3[0]=PKW(P1,8), pw3[1]=PKW(P1,10), pw3); \
    VRD(7); SBAR(); GAPA(C1=__builtin_amdgcn_mfma_f32_32x32x16_bf16(kf[7],qr[3],C1,0,0,0),   P1[14],P1[15],0.f,0.f,       pw3[2]=PKW(P1,12),pw3[3]=PKW(P1,14), pw3); \
    l_reg+=sacc; \
    if(GK){DMA_K((t)+3,sl_cur);} if(GV){DMA_V((t)+1,sl_next);} \
    CMASK(C0,C1,t); \
    { float a=MX3(C0[0],C0[1],C1[0]),b=MX3(C0[2],C0[3],C1[1]); a=MX3(a,C1[2],C1[3]); \
      _Pragma("unroll") for(int r=4;r<16;r+=4){a=MX3(a,C0[r],C0[r+1]);b=MX3(b,C0[r+2],C0[r+3]);a=MX3(a,C1[r],C1[r+1]);b=MX3(b,C1[r+2],C1[r+3]);} \
      float rm=__builtin_fmaxf(a,b); { auto rr=__builtin_amdgcn_permlane32_swap(__float_as_uint(rm),__float_as_uint(rm),false,false); rm=__builtin_fmaxf(__uint_as_float(rr[0]),__uint_as_float(rr[1])); } \
      resc=false; \
      if(__builtin_expect(__any(rm>(float)THRL),0)){ const float dl=__builtin_fmaxf(rm,0.f); mhat+=dl; \
        _Pragma("unroll") for(int r=0;r<16;++r){C0[r]-=dl;C1[r]-=dl;} \
        _Pragma("unroll") for(int r=0;r<16;++r)negm[r]=-mhat; asm volatile("":"+v"(negm)); \
        const float f=__builtin_amdgcn_exp2f(-dl); l_reg*=f; if(hi==0)wsf[r32]=f; resc=true; } } \
    SBAR(); \
    GAPB(o[0]=__builtin_amdgcn_mfma_f32_32x32x16_bf16(PAF(0),VFR(0),o[0],0,0,0), C0,0); \
    GAPB(o[1]=__builtin_amdgcn_mfma_f32_32x32x16_bf16(PAF(0),VFR(4),o[1],0,0,0), C0,4); \
    KRD(GL,0); GAPB(o[0]=__builtin_amdgcn_mfma_f32_32x32x16_bf16(PAF(1),VFR(1),o[0],0,0,0), C0,8); \
    KRD(GL,1); GAPB(o[1]=__builtin_amdgcn_mfma_f32_32x32x16_bf16(PAF(1),VFR(5),o[1],0,0,0), C0,12); \
    KRD(GL,2); GAPB(o[0]=__builtin_amdgcn_mfma_f32_32x32x16_bf16(PAF(2),VFR(2),o[0],0,0,0), C1,0); \
    KRD(GL,3); GAPB(o[1]=__builtin_amdgcn_mfma_f32_32x32x16_bf16(PAF(2),VFR(6),o[1],0,0,0), C1,4); \
    GAPB(o[0]=__builtin_amdgcn_mfma_f32_32x32x16_bf16(PAF(3),VFR(3),o[0],0,0,0), C1,8); \
    GAPB(o[1]=__builtin_amdgcn_mfma_f32_32x32x16_bf16(PAF(3),VFR(7),o[1],0,0,0), C1,12); \
    }while(0)
  int t=1;
  #undef CMASK
  #define CMASK(P0,P1,t) do{}while(0)
  for(;t+5<NT;t+=2){
    STEP(pB0,pB1,pA0,pA1,t,true,true,true);     WAIT_BAR(2); RESC(); ROT();
    STEP(pA0,pA1,pB0,pB1,t+1,true,true,true);   WAIT_BAR(2); RESC(); ROT();
  }
  #undef CMASK
  #define CMASK(P0,P1,t) do{int jb_=(t)-(NT-4); if(jb_>=0)cmask(P0,P1,jb_,qrel,hi);}while(0)
  #define ENDW(tt) do{ if((tt)+3<NT){WAIT_BAR(2);} else if((tt)+2<NT){WAIT_BAR(1);} else {WAIT_BAR(0);} }while(0)
  for(;t+1<NT;t+=2){
    STEP(pB0,pB1,pA0,pA1,t,(t+3<NT),(t+1<NT),(t+1<NT));       ENDW(t);   RESC(); ROT();
    STEP(pA0,pA1,pB0,pB1,t+1,(t+4<NT),(t+2<NT),(t+2<NT));     ENDW(t+1); RESC(); ROT();
  }
  STEP(pB0,pB1,pA0,pA1,NT-1,false,false,false); RESC();
  { float sacc=pB0[0]+pB0[1]; _Pragma("unroll") for(int r=2;r<16;++r)sacc+=pB0[r]; _Pragma("unroll") for(int r=0;r<16;++r)sacc+=pB1[r]; l_reg+=sacc;
    pw0=(u32x4){PKW(pB0,0),PKW(pB0,2),PKW(pB0,4),PKW(pB0,6)};pw1=(u32x4){PKW(pB0,8),PKW(pB0,10),PKW(pB0,12),PKW(pB0,14)};pw2=(u32x4){PKW(pB1,0),PKW(pB1,2),PKW(pB1,4),PKW(pB1,6)};pw3=(u32x4){PKW(pB1,8),PKW(pB1,10),PKW(pB1,12),PKW(pB1,14)};
    SBAR(); pv(o,vb0+sl_cur,PAF(0),PAF(1),PAF(2),PAF(3)); }
  #undef PKW
  #undef PAF
  #undef VFR
  #undef PIN
  #undef MX3
  #undef GAPA
  #undef GAPB
  #undef EX
  #undef VRD
  #undef KRD
  #undef STEP
  #undef ENDW
  {auto rr=__builtin_amdgcn_permlane32_swap(__float_as_uint(l_reg),__float_as_uint(l_reg),false,false);l_reg=__uint_as_float(rr[0])+__uint_as_float(rr[1]);}
  if(hi==0)wsf[32+r32]=l_reg;asm volatile("s_waitcnt lgkmcnt(0)":::"memory");
  float rli[16];
  #pragma unroll
  for(int r=0;r<16;++r)rli[r]=__builtin_amdgcn_rcpf(wsf[32+crow(r,hi)]);
  bf16*Ow=O+(rowbase+q0+wid*QBLK)*DM+hv*D;
  { bf16*stg=(bf16*)(shm+LDS_OST)+wid*2048;
    #pragma unroll
    for(int r=0;r<16;++r){const int orow=crow(r,hi);
      #pragma unroll
      for(int d0=0;d0<2;++d0)stg[orow*64+d0*32+r32]=__float2bfloat16(o[d0][r]*rli[r]);}
    asm volatile("s_waitcnt lgkmcnt(0)":::"memory");
    #pragma unroll
    for(int i=0;i<4;++i){const int row=i*8+(lane>>3),ch=lane&7; const u32x4 v=*(const u32x4*)(stg+row*64+ch*8); ATTN_STORE16(Ow+(long)row*DM+ch*8,v);} }
  asm volatile("s_waitcnt lgkmcnt(0)\n\ts_barrier":::"memory");
  #undef DMA_K
  #undef DMA_V
  #undef CMASK
  #undef START
  #undef RESC
  #undef ROT
}
constexpr int ATTN_LDS_BYTES=LDS_BYTES;
struct AttnTensors { const bf16* Q; const bf16* K; const bf16* V; bf16* O1; bf16* O2; };
struct AttnUnit { int combo; int qb; };
struct StaticOrder {
  int vcu,G,blk;
  __device__ __forceinline__ explicit StaticOrder(int grid,int block):vcu((grid%8==0)?(block%8)*(grid/8)+block/8:block),G(grid),blk(block){}
  __device__ __forceinline__ bool next(int i,AttnUnit&u)const{
    if(G==256){ if(i>=32)return false; const int s=vcu&7,j=i&3; u.combo=(i>>2)*32+(vcu>>3); u.qb=(j==0)?s:(j==1)?15-s:(j==2)?16+s:31-s; return true; }
    const long L=(long)i*G+blk; if(L>=8192)return false; u.combo=(int)(L>>5); u.qb=31-(int)(L&31); return true; }
};
template<class Sched,int THRL=8> __device__ __forceinline__ void attn_phase(char*lds,const AttnTensors&T,const Sched&S){
  AttnUnit u;
  for(int i=0;S.next(i,u);++i){ const int b=u.combo>>5,hq=(u.combo>>1)&15,vh=u.combo&1; const int hv=(hq>>1)*2+vh;
    attn_unit<THRL>(b,hq,hv,u.qb,T.Q,T.K,T.V,(hq&1)?T.O2:T.O1,lds); }
}
#undef SBAR
#undef WAIT_BAR
}

#include <hip/hip_cooperative_groups.h>
namespace cg = cooperative_groups;

constexpr int NWAVES = 8;
#ifndef STOP_AFTER
#define STOP_AFTER 99
#endif
constexpr int DM = 1024, FF = 4096, NP = 65536, NS = 256, M = NP + NS;
constexpr float EPS = 1e-6f;
constexpr float LAM_INIT = 0.35550906759f;
constexpr size_t O_Y = 0, O_KP = (size_t)M * DM, O_VP = O_KP + (size_t)NP * DM, O_STP = O_VP + (size_t)NP * DM, O_KS = O_STP + (size_t)8 * 8 * 128 * 128,
                 O_VS = O_KS + (size_t)NS * DM, O_STS = O_VS + (size_t)NS * DM, O_END = O_STS + (size_t)16 * 8 * 128 * 128;
constexpr size_t MiB = 1u << 20;
constexpr size_t WS_OML = 1 * MiB;
constexpr size_t WS_WIN = 2 * MiB, WS_WHO = 10 * MiB, WS_WUP0 = 12 * MiB, WS_WDN0 = 20 * MiB, WS_WQKV = 28 * MiB, WS_WDO = 34 * MiB, WS_WUP1 = 36 * MiB, WS_WDN1 = 44 * MiB;
constexpr size_t WS_XN = 64 * MiB;
constexpr size_t WS_MB = 196 * MiB;
constexpr size_t WS_R0 = 328 * MiB;
constexpr size_t WS_Q = WS_R0, WS_K = WS_R0 + 130 * MiB, WS_V = WS_R0 + 260 * MiB, WS_O1 = WS_R0 + 390 * MiB;
constexpr size_t WS_O2 = WS_R0 + 520 * MiB;
constexpr size_t WS_PACC = WS_O2 + 130 * MiB;
constexpr size_t WS_END = WS_PACC + 4 * MiB;
constexpr int SPLK = 4;
constexpr size_t WS_RS = 1 * MiB + 65536;
static_assert(WS_O2 + (size_t)M * DM * 2 <= WS_END && WS_END <= 1024 * MiB && WS_O1 + (size_t)M * DM * 2 <= WS_O2 && WS_R0 + (size_t)M * FF * 2 <= WS_END && WS_XN + (size_t)M * DM * 2 <= WS_MB && WS_MB + (size_t)M * DM * 2 <= WS_R0, "d_ws map");

constexpr int RING_OFF = 0, RING_BYTES = 131072;
constexpr int LDS_BYTES = 155648;

#define GAS __attribute__((address_space(1)))
#define LAS __attribute__((address_space(3)))
typedef unsigned short bf16;
typedef unsigned v4u __attribute__((ext_vector_type(4)));
typedef unsigned v2u __attribute__((ext_vector_type(2)));
typedef float f32x4 __attribute__((ext_vector_type(4)));
typedef short bf16x8 __attribute__((ext_vector_type(8)));
#define LDS_WAIT() asm volatile("s_waitcnt lgkmcnt(0)" ::: "memory")
__device__ __forceinline__ unsigned pk2(float lo, float hi) { return pg8::cvt_pk_bf16(lo, hi); }
__device__ __forceinline__ float bf2f(unsigned short u) { return __uint_as_float((unsigned)u << 16); }
__device__ __forceinline__ float bflo(unsigned u) { return __uint_as_float(u << 16); }
__device__ __forceinline__ float bfhi(unsigned u) { return __uint_as_float(u & 0xffff0000u); }
template <int CTRL> __device__ __forceinline__ float dpp_f(float v) { return __builtin_bit_cast(float, __builtin_amdgcn_update_dpp(0, __builtin_bit_cast(int, v), CTRL, 0xf, 0xf, true)); }
__device__ __forceinline__ float wave_sum(float v) {
#pragma unroll
    for (int o = 1; o < 64; o <<= 1) v += __shfl_xor(v, o);
    return v;
}
__device__ __forceinline__ float wave_max(float v) {
#pragma unroll
    for (int o = 1; o < 64; o <<= 1) v = fmaxf(v, __shfl_xor(v, o));
    return v;
}

struct Frame {
    LAS unsigned char* lds;
    int tid, lane, wave, vcu, G;
};

__device__ __forceinline__ void p0_transpose_item(const float* W, const float* gain, int K, int N, bf16* WT, int row_off, LAS float* scr, int item, int lane) {
    const int nblk = N / 32, kb = item / nblk, nb = item % nblk, k0 = 64 * kb, n0 = 32 * nb;
    if (gain) {
        float wv[32], gv[32];
#pragma unroll
        for (int i = 0; i < 32; ++i) { const int kk = 2 * i + (lane >> 5); wv[i] = W[(size_t)(k0 + kk) * N + n0 + (lane & 31)]; gv[i] = gain[k0 + kk]; }
#pragma unroll
        for (int i = 0; i < 32; ++i) { const int kk = 2 * i + (lane >> 5); scr[kk * 33 + (lane & 31)] = gv[i] * wv[i]; }
    } else {
        float wv[32];
#pragma unroll
        for (int i = 0; i < 32; ++i) { const int kk = 2 * i + (lane >> 5); wv[i] = W[(size_t)(k0 + kk) * N + n0 + (lane & 31)]; }
#pragma unroll
        for (int i = 0; i < 32; ++i) { const int kk = 2 * i + (lane >> 5); scr[kk * 33 + (lane & 31)] = wv[i]; }
    }
    LDS_WAIT(); asm volatile("" ::: "memory");
    const int c = lane & 7;
#pragma unroll
    for (int j = 0; j < 4; ++j) { const int n = (lane >> 3) + 8 * j; const LAS float* s = scr + (8 * c) * 33 + n;
        v4u o; o.x = pk2(s[0 * 33], s[1 * 33]); o.y = pk2(s[2 * 33], s[3 * 33]); o.z = pk2(s[4 * 33], s[5 * 33]); o.w = pk2(s[6 * 33], s[7 * 33]);
        *(v4u*)(WT + (size_t)(row_off + n0 + n) * K + k0 + 8 * c) = o; }
    LDS_WAIT(); asm volatile("" ::: "memory");
}

struct Args {
    const float* in[18]; float* out; unsigned char* ws;
};

__device__ __forceinline__ void rms_row_to_bf16(const float* xrow, bf16* orow, float* rs, int lane) {
    const f32x4* xr = (const f32x4*)xrow;
    f32x4 v[4]; v[0] = xr[2 * lane]; v[1] = xr[2 * lane + 1]; v[2] = xr[128 + 2 * lane]; v[3] = xr[128 + 2 * lane + 1];
    float s = 0.f;
#pragma unroll
    for (int j = 0; j < 4; ++j) s += (v[j].x * v[j].x + v[j].y * v[j].y) + (v[j].z * v[j].z + v[j].w * v[j].w);
    const float ms = wave_sum(s) * (1.f / DM) + EPS; const float r = rsqrtf(ms);
    if (lane == 0) *rs = sqrtf(ms);
    v4u o0, o1;
    o0.x = pk2(v[0].x * r, v[0].y * r); o0.y = pk2(v[0].z * r, v[0].w * r); o0.z = pk2(v[1].x * r, v[1].y * r); o0.w = pk2(v[1].z * r, v[1].w * r);
    o1.x = pk2(v[2].x * r, v[2].y * r); o1.y = pk2(v[2].z * r, v[2].w * r); o1.z = pk2(v[3].x * r, v[3].y * r); o1.w = pk2(v[3].z * r, v[3].w * r);
    *(v4u*)(orow + 8 * lane) = o0; *(v4u*)(orow + 512 + 8 * lane) = o1;
}

template <bool LAST>
__device__ __forceinline__ void norm_phase(const Frame& F, const bf16* MB, const float* pacc, const float* gpost, float* RS, float* out, bf16* XN) {
    const int gw = F.vcu * NWAVES + F.wave, NGW = F.G * NWAVES, lane = F.lane;
    f32x4 g[4]; { const f32x4* gp = (const f32x4*)gpost; g[0] = gp[2 * lane]; g[1] = gp[2 * lane + 1]; g[2] = gp[128 + 2 * lane]; g[3] = gp[128 + 2 * lane + 1]; }
    for (int row = gw; row < M; row += NGW) {
        const v4u m0 = *(const v4u*)(MB + (size_t)row * DM + 8 * lane), m1 = *(const v4u*)(MB + (size_t)row * DM + 512 + 8 * lane);
        const v4u x0 = *(const v4u*)(XN + (size_t)row * DM + 8 * lane), x1 = *(const v4u*)(XN + (size_t)row * DM + 512 + 8 * lane);
        const float hs = RS[row];
        f32x4 v[4], mm[4];
        v[0] = (f32x4){bflo(x0.x), bfhi(x0.x), bflo(x0.y), bfhi(x0.y)}; v[1] = (f32x4){bflo(x0.z), bfhi(x0.z), bflo(x0.w), bfhi(x0.w)};
        v[2] = (f32x4){bflo(x1.x), bfhi(x1.x), bflo(x1.y), bfhi(x1.y)}; v[3] = (f32x4){bflo(x1.z), bfhi(x1.z), bflo(x1.w), bfhi(x1.w)};
        mm[0] = (f32x4){bflo(m0.x), bfhi(m0.x), bflo(m0.y), bfhi(m0.y)}; mm[1] = (f32x4){bflo(m0.z), bfhi(m0.z), bflo(m0.w), bfhi(m0.w)};
        mm[2] = (f32x4){bflo(m1.x), bfhi(m1.x), bflo(m1.y), bfhi(m1.y)}; mm[3] = (f32x4){bflo(m1.z), bfhi(m1.z), bflo(m1.w), bfhi(m1.w)};
        if (row >= NP) {
            const f32x4* pp = (const f32x4*)(pacc + (size_t)(row - NP) * DM);
            mm[0] = pp[2 * lane]; mm[1] = pp[2 * lane + 1]; mm[2] = pp[128 + 2 * lane]; mm[3] = pp[128 + 2 * lane + 1];
#pragma unroll
            for (int p = 1; p < SPLK; ++p) { const f32x4* pq_ = pp + (size_t)p * (NS * DM / 4); mm[0] += pq_[2 * lane]; mm[1] += pq_[2 * lane + 1]; mm[2] += pq_[128 + 2 * lane]; mm[3] += pq_[128 + 2 * lane + 1]; }
        }
        float s = 0.f;
#pragma unroll
        for (int j = 0; j < 4; ++j) s += (mm[j].x * mm[j].x + mm[j].y * mm[j].y) + (mm[j].z * mm[j].z + mm[j].w * mm[j].w);
        const float r = rsqrtf(wave_sum(s) * (1.f / DM) + EPS);
        float s2 = 0.f;
#pragma unroll
        for (int j = 0; j < 4; ++j) { v[j] = v[j] * hs + mm[j] * r * g[j]; s2 += (v[j].x * v[j].x + v[j].y * v[j].y) + (v[j].z * v[j].z + v[j].w * v[j].w); }
        if (LAST) {
            f32x4* dr = (f32x4*)(out + (size_t)row * DM);
            dr[2 * lane] = v[0]; dr[2 * lane + 1] = v[1]; dr[128 + 2 * lane] = v[2]; dr[128 + 2 * lane + 1] = v[3];
        } else {
            const float ms = wave_sum(s2) * (1.f / DM) + EPS; const float r2 = rsqrtf(ms);
            if (lane == 0) RS[row] = sqrtf(ms);
            v4u o0, o1;
            o0.x = pk2(v[0].x * r2, v[0].y * r2); o0.y = pk2(v[0].z * r2, v[0].w * r2); o0.z = pk2(v[1].x * r2, v[1].y * r2); o0.w = pk2(v[1].z * r2, v[1].w * r2);
            o1.x = pk2(v[2].x * r2, v[2].y * r2); o1.y = pk2(v[2].z * r2, v[2].w * r2); o1.z = pk2(v[3].x * r2, v[3].y * r2); o1.w = pk2(v[3].z * r2, v[3].w * r2);
            *(v4u*)(XN + (size_t)row * DM + 8 * lane) = o0; *(v4u*)(XN + (size_t)row * DM + 512 + 8 * lane) = o1;
        }
    }
}

__device__ __forceinline__ float compute_lam(const float* lp, int lane) {
    const float a = wave_sum(lp[lane] * lp[64 + lane]), b = wave_sum(lp[128 + lane] * lp[192 + lane]);
    return __expf(a) - __expf(b) + LAM_INIT;
}

__device__ __forceinline__ void combine_phase(const Frame& F, const bf16* O1, const bf16* O2, const float* lp, const float* subg, bf16* OC) {
    const int gw = F.vcu * NWAVES + F.wave, NGW = F.G * NWAVES, lane = F.lane;
    const float lam = compute_lam(lp, lane);
    float sg[16];
#pragma unroll
    for (int e = 0; e < 16; ++e) sg[e] = subg[16 * (lane & 7) + e] * (1.0f - LAM_INIT);
    for (int row = gw; row < NP; row += NGW) {
        const size_t off = (size_t)row * DM + 16 * lane;
        const v4u a0 = *(const v4u*)(O1 + off), a1 = *(const v4u*)(O1 + off + 8), b0 = *(const v4u*)(O2 + off), b1 = *(const v4u*)(O2 + off + 8);
        float o[16];
        const unsigned aw[8] = {a0.x, a0.y, a0.z, a0.w, a1.x, a1.y, a1.z, a1.w}, bw[8] = {b0.x, b0.y, b0.z, b0.w, b1.x, b1.y, b1.z, b1.w};
        float s = 0.f;
#pragma unroll
        for (int e = 0; e < 8; ++e) { o[2 * e] = bflo(aw[e]) - lam * bflo(bw[e]); o[2 * e + 1] = bfhi(aw[e]) - lam * bfhi(bw[e]); s += o[2 * e] * o[2 * e] + o[2 * e + 1] * o[2 * e + 1]; }
        s += __shfl_xor(s, 1); s += __shfl_xor(s, 2); s += __shfl_xor(s, 4);
        const float r = rsqrtf(s * (1.f / 128.f) + EPS);
        v4u w0, w1;
        w0.x = pk2(o[0] * r * sg[0], o[1] * r * sg[1]); w0.y = pk2(o[2] * r * sg[2], o[3] * r * sg[3]); w0.z = pk2(o[4] * r * sg[4], o[5] * r * sg[5]); w0.w = pk2(o[6] * r * sg[6], o[7] * r * sg[7]);
        w1.x = pk2(o[8] * r * sg[8], o[9] * r * sg[9]); w1.y = pk2(o[10] * r * sg[10], o[11] * r * sg[11]); w1.z = pk2(o[12] * r * sg[12], o[13] * r * sg[13]); w1.w = pk2(o[14] * r * sg[14], o[15] * r * sg[15]);
        *(v4u*)(OC + off) = w0; *(v4u*)(OC + off + 8) = w1;
    }
}

namespace hg {
#define HGT 0
constexpr int QT_P = 136, KH_P = 72, ST_P = 136;
constexpr int L_QT = 0, L_KT = 17408, L_KHT = 34816, L_VT = 53248, L_AM = 71680, L_ST = 80896, L_BSUM = 115712, L_DL = 117760, L_SSQ = 118272, L_OST = 118784, OST_P = 72, L_RV = L_OST + 8 * 16 * OST_P * 2, L_END = L_RV + 64 * QT_P * 2;
static_assert(L_END <= LDS_BYTES, "hgrn LDS");
#define HG_MFMA(a, b, c) __builtin_amdgcn_mfma_f32_16x16x32_bf16((a), (b), (c), 0, 0, 0)
template <int ntok>
__device__ __forceinline__ void hgrn_item(LAS unsigned char* lds, const bf16* HG, bf16* OUT, const float* S0, float* Sout, long row0, int nchunk, int h, const float* onorm_g) {
    int tid_ = threadIdx.x; asm volatile("" : "+v"(tid_));
    const int tid = tid_, lane = tid & 63, wid = __builtin_amdgcn_readfirstlane(tid >> 6);
    const int kc = tid & 127, qt = wid >> 1, fr = lane & 15, fq = lane >> 4;
    LAS bf16* Qt = (LAS bf16*)(lds + L_QT); LAS bf16* Kt = (LAS bf16*)(lds + L_KT); LAS bf16* KhT = (LAS bf16*)(lds + L_KHT); LAS bf16* VT = (LAS bf16*)(lds + L_VT);
    LAS bf16* Am = (LAS bf16*)(lds + L_AM); LAS bf16* ST = (LAS bf16*)(lds + L_ST);
    LAS bf16* ost = (LAS bf16*)(lds + L_OST) + wid * (16 * OST_P);
    LAS float* bsum = (LAS float*)(lds + L_BSUM); LAS float* dlast = (LAS float*)(lds + L_DL); LAS float* ssq = (LAS float*)(lds + L_SSQ);
    const int ti = wid >> 1, vh = wid & 1;
    f32x4 sacc[8];
#pragma unroll
    for (int vt = 0; vt < 8; ++vt) {
#pragma unroll
        for (int i = 0; i < 4; ++i) sacc[vt][i] = S0 ? S0[(size_t)(16 * wid + 4 * fq + i) * 128 + 16 * vt + fr] : 0.f;
    }
    __syncthreads();
#pragma unroll
    for (int vt = 0; vt < 8; ++vt) { v2u w; w.x = pk2(sacc[vt][0], sacc[vt][1]); w.y = pk2(sacc[vt][2], sacc[vt][3]); *(LAS v2u*)(ST + (16 * vt + fr) * ST_P + 16 * wid + 4 * fq) = w; }
    float og[4];
#pragma unroll
    for (int j = 0; j < 4; ++j) og[j] = onorm_g[h * 128 + 16 * (4 * vh + j) + fr];
    LAS bf16* RV = (LAS bf16*)(lds + L_RV);
    v4u pq[2], pk[2], pv[2], pg[2];
#define HG_LOAD(c) do { _Pragma("unroll") for (int e = 0; e < 2; ++e) { const int id = tid + 512 * e, r_ = id >> 4, pc = id & 15; const int rc = (ntok >= 64 || r_ < ntok) ? r_ : ntok - 1; \
            const bf16* p = HG + (size_t)(row0 + (long)(c) * 64 + rc) * 4096 + h * 128 + pc * 8; pq[e] = *(const v4u*)p; pk[e] = *(const v4u*)(p + 1024); pv[e] = *(const v4u*)(p + 2048); } \
        _Pragma("unroll") for (int hh = 0; hh < 2; ++hh) { const int r_ = 16 * ti + (lane >> 2); const int rc = (ntok >= 64 || r_ < ntok) ? r_ : ntok - 1; \
            pg[hh] = *(const v4u*)(HG + (size_t)(row0 + (long)(c) * 64 + rc) * 4096 + 3072 + h * 128 + 64 * vh + 8 * ((lane & 3) + 4 * hh)); } } while (0)
    HG_LOAD(0);
    for (int c = 0; c < nchunk; ++c) {
        float q[16], k[16]; unsigned vpk[8]; v4u gcur[2];
#pragma unroll
        for (int e = 0; e < 2; ++e) { const int id = tid + 512 * e, r_ = id >> 4, pc = id & 15;
            *(LAS v4u*)(Qt + r_ * QT_P + pc * 8) = pq[e]; *(LAS v4u*)(Kt + r_ * QT_P + pc * 8) = pk[e]; *(LAS v4u*)(RV + r_ * QT_P + pc * 8) = pv[e]; }
        gcur[0] = pg[0]; gcur[1] = pg[1];
        if (c + 1 < nchunk) HG_LOAD(c + 1);
        __syncthreads();
        { unsigned short rv[16];
#pragma unroll
          for (int i = 0; i < 16; ++i) { const bool ok = (ntok >= 64) || (16 * qt + i) < ntok; const int o_ = (16 * qt + i) * QT_P + kc;
              const unsigned short tq_ = Qt[o_], tk_ = Kt[o_], tv_ = RV[o_]; q[i] = ok ? bf2f(tq_) : 0.f; k[i] = ok ? bf2f(tk_) : 0.f; rv[i] = ok ? tv_ : (unsigned short)0; }
#pragma unroll
          for (int i = 0; i < 8; ++i) vpk[i] = (unsigned)rv[2 * i] | ((unsigned)rv[2 * i + 1] << 16); }
        float g[16]; float run = 1.f;
#pragma unroll
        for (int i = 0; i < 16; ++i) { run *= (1.0f - k[i]); g[i] = run; }
        bsum[qt * 128 + kc] = run;
        __syncthreads();
        float off = 1.f, tot = 1.f;
#pragma unroll
        for (int j = 0; j < 4; ++j) { const float s_ = bsum[j * 128 + kc]; tot *= s_; off *= (j < qt) ? s_ : 1.f; }
        unsigned khp[8];
#pragma unroll
        for (int i = 0; i < 16; i += 2) {
            const float p0 = off * g[i], p1 = off * g[i + 1]; const float r0 = __builtin_amdgcn_rcpf(p0), r1 = __builtin_amdgcn_rcpf(p1);
            const unsigned qq = pk2(q[i] * p0, q[i + 1] * p1), kk = pk2(k[i] * r0, k[i + 1] * r1);
            Qt[(16 * qt + i) * QT_P + kc] = (bf16)(qq & 0xffffu); Qt[(16 * qt + i + 1) * QT_P + kc] = (bf16)(qq >> 16);
            Kt[(16 * qt + i) * QT_P + kc] = (bf16)(kk & 0xffffu); Kt[(16 * qt + i + 1) * QT_P + kc] = (bf16)(kk >> 16);
            khp[i >> 1] = pk2(k[i] * (tot * r0), k[i + 1] * (tot * r1));
        }
        *(LAS v4u*)(KhT + kc * KH_P + 16 * qt) = (v4u){khp[0], khp[1], khp[2], khp[3]}; *(LAS v4u*)(KhT + kc * KH_P + 16 * qt + 8) = (v4u){khp[4], khp[5], khp[6], khp[7]};
        *(LAS v4u*)(VT + kc * KH_P + 16 * qt) = (v4u){vpk[0], vpk[1], vpk[2], vpk[3]}; *(LAS v4u*)(VT + kc * KH_P + 16 * qt + 8) = (v4u){vpk[4], vpk[5], vpk[6], vpk[7]};
        if (qt == 0) dlast[kc] = tot;
        __syncthreads();
        { bf16x8 af[4];
#pragma unroll
          for (int kk = 0; kk < 4; ++kk) af[kk] = *(const LAS bf16x8*)(Qt + (16 * ti + fr) * QT_P + 32 * kk + 8 * fq);
#pragma unroll
          for (int jj = 0; jj < 2; ++jj) { const int sj = 2 * vh + jj;
            f32x4 a = (f32x4){0.f, 0.f, 0.f, 0.f};
            if (sj <= ti) { bf16x8 bfr[4];
#pragma unroll
                for (int kk = 0; kk < 4; ++kk) bfr[kk] = *(const LAS bf16x8*)(Kt + (16 * sj + fr) * QT_P + 32 * kk + 8 * fq);
                __builtin_amdgcn_sched_barrier(0);
#pragma unroll
                for (int kk = 0; kk < 4; ++kk) a = HG_MFMA(af[kk], bfr[kk], a);
            }
#pragma unroll
            for (int i = 0; i < 4; ++i) { const int t = 16 * ti + 4 * fq + i, s_ = 16 * sj + fr; const float val = (s_ <= t) ? a[i] : 0.f; Am[t * KH_P + s_] = (bf16)(pk2(val, 0.f) & 0xffffu); }
          } }
        __syncthreads();
        f32x4 oacc[4];
        { bf16x8 aA[2], aQ[4], bb[2][6];
#pragma unroll
          for (int kk = 0; kk < 2; ++kk) aA[kk] = *(const LAS bf16x8*)(Am + (16 * ti + fr) * KH_P + 32 * kk + 8 * fq);
#pragma unroll
          for (int kk = 0; kk < 4; ++kk) aQ[kk] = *(const LAS bf16x8*)(Qt + (16 * ti + fr) * QT_P + 32 * kk + 8 * fq);
#define HG_LDB(dst, vt_) do { _Pragma("unroll") for (int kk = 0; kk < 2; ++kk) dst[kk] = *(const LAS bf16x8*)(VT + (16 * (vt_) + fr) * KH_P + 32 * kk + 8 * fq); \
              _Pragma("unroll") for (int kk = 0; kk < 4; ++kk) dst[2 + kk] = *(const LAS bf16x8*)(ST + (16 * (vt_) + fr) * ST_P + 32 * kk + 8 * fq); } while (0)
          HG_LDB(bb[0], 4 * vh);
#pragma unroll
          for (int j = 0; j < 4; ++j) { f32x4 o = (f32x4){0.f, 0.f, 0.f, 0.f};
              if (j + 1 < 4) HG_LDB(bb[(j + 1) & 1], 4 * vh + j + 1);
              __builtin_amdgcn_sched_barrier(0);
#pragma unroll
              for (int kk = 0; kk < 2; ++kk) o = HG_MFMA(aA[kk], bb[j & 1][kk], o);
#pragma unroll
              for (int kk = 0; kk < 4; ++kk) o = HG_MFMA(aQ[kk], bb[j & 1][2 + kk], o);
              oacc[j] = o; }
#undef HG_LDB
        }
#pragma unroll
        for (int i = 0; i < 4; ++i) { float p = 0.f;
#pragma unroll
            for (int j = 0; j < 4; ++j) p += oacc[j][i] * oacc[j][i];
            p += dpp_f<0xB1>(p); p += dpp_f<0x4E>(p); p += dpp_f<0x124>(p); p += dpp_f<0x128>(p);
            if (fr == 0) ssq[vh * 64 + 16 * ti + 4 * fq + i] = p; }
        __syncthreads();
#pragma unroll
        for (int i = 0; i < 4; ++i) { const int t = 16 * ti + 4 * fq + i; const float r = rsqrtf((ssq[t] + ssq[64 + t]) * (1.f / 128.f) + EPS);
#pragma unroll
            for (int j = 0; j < 4; ++j) ost[(4 * fq + i) * OST_P + 16 * j + fr] = (bf16)(pk2(oacc[j][i] * r * og[j], 0.f) & 0xffffu); }
        asm volatile("s_waitcnt lgkmcnt(0)" ::: "memory");
#pragma unroll
        for (int hh = 0; hh < 2; ++hh) { const int orow = lane >> 2, och = (lane & 3) + 4 * hh; const v4u w = *(const LAS v4u*)(ost + orow * OST_P + 8 * och); const v4u gg = gcur[hh];
            v4u o4; o4.x = pk2(bflo(w.x) * bflo(gg.x), bfhi(w.x) * bfhi(gg.x)); o4.y = pk2(bflo(w.y) * bflo(gg.y), bfhi(w.y) * bfhi(gg.y));
            o4.z = pk2(bflo(w.z) * bflo(gg.z), bfhi(w.z) * bfhi(gg.z)); o4.w = pk2(bflo(w.w) * bflo(gg.w), bfhi(w.w) * bfhi(gg.w));
            if (ntok >= 64 || 16 * ti + orow < ntok) *(v4u*)(OUT + (size_t)(row0 + (long)c * 64 + 16 * ti + orow) * DM + h * 128 + 64 * vh + 8 * och) = o4; }
        asm volatile("s_waitcnt lgkmcnt(0)" ::: "memory");
        { float d[4];
#pragma unroll
          for (int i = 0; i < 4; ++i) d[i] = dlast[16 * wid + 4 * fq + i];
          bf16x8 aK[2];
#pragma unroll
          for (int kk = 0; kk < 2; ++kk) aK[kk] = *(const LAS bf16x8*)(KhT + (16 * wid + fr) * KH_P + 32 * kk + 8 * fq);
#pragma unroll
          for (int g4 = 0; g4 < 2; ++g4) { bf16x8 bv[4][2];
#pragma unroll
              for (int u = 0; u < 4; ++u)
#pragma unroll
                  for (int kk = 0; kk < 2; ++kk) bv[u][kk] = *(const LAS bf16x8*)(VT + (16 * (4 * g4 + u) + fr) * KH_P + 32 * kk + 8 * fq);
              __builtin_amdgcn_sched_barrier(0);
#pragma unroll
              for (int u = 0; u < 4; ++u) { const int vt = 4 * g4 + u; f32x4 a = sacc[vt];
#pragma unroll
                  for (int i = 0; i < 4; ++i) a[i] *= d[i];
#pragma unroll
                  for (int kk = 0; kk < 2; ++kk) a = HG_MFMA(aK[kk], bv[u][kk], a);
                  sacc[vt] = a;
                  v2u w; w.x = pk2(a[0], a[1]); w.y = pk2(a[2], a[3]); *(LAS v2u*)(ST + (16 * vt + fr) * ST_P + 16 * wid + 4 * fq) = w; } } }
    }
#undef HG_LOAD
#pragma unroll
    for (int vt = 0; vt < 8; ++vt) {
#pragma unroll
        for (int i = 0; i < 4; ++i) Sout[(size_t)(16 * wid + 4 * fq + i) * 128 + 16 * vt + fr] = sacc[vt][i];
    }
    __syncthreads();
}
}

namespace sa {
constexpr int SCP = 1044, NQ = 8;
constexpr int L_Q = 0, L_SC = 8192, L_OACC = L_SC + NQ * SCP * 4, L_O0 = L_OACC + 4 * NQ * 128 * 4, L_END = L_O0 + NQ * 128 * 4;
static_assert(L_END <= RING_BYTES, "sample attention LDS");
__device__ __forceinline__ void item(LAS unsigned char* lds, int it2, const bf16* Qb, const bf16* Kb, const bf16* Vb, const float* ck, const float* cv, bf16* OC, float lam, const float* subg) {
    int tid_ = threadIdx.x; asm volatile("" : "+v"(tid_));
    const int tid = tid_, lane = tid & 63, wid = __builtin_amdgcn_readfirstlane(tid >> 6);
    const int it = it2 >> 1, q0 = (it2 & 1) * NQ, b = it >> 3, h = it & 7;
    LAS float* Qs = (LAS float*)(lds + L_Q); LAS float* SC = (LAS float*)(lds + L_SC); LAS float* OA = (LAS float*)(lds + L_OACC); LAS float* O0 = (LAS float*)(lds + L_O0);
    const size_t srow = (size_t)NP + (size_t)b * 16;
    __syncthreads();
    if (tid < 256) { const int idx = tid * 4, c = idx >> 9, qq = (idx >> 6) & 7, d = idx & 63;
      const v2u w = *(const v2u*)(Qb + (srow + q0 + qq) * DM + h * 128 + c * 64 + d);
      Qs[idx] = bflo(w.x); Qs[idx + 1] = bfhi(w.x); Qs[idx + 2] = bflo(w.y); Qs[idx + 3] = bfhi(w.y); }
    __syncthreads();
    for (int c = 0; c < 2; ++c) {
        for (int key = tid; key < 1040; key += 512) {
            float s[NQ];
            float kd[64];
            if (key < 1024) { const f32x4* kp = (const f32x4*)(ck + (((size_t)b * 1024 + key) * 8 + h) * 128 + c * 64);
#pragma unroll
                for (int j = 0; j < 16; ++j) { const f32x4 t4 = kp[j]; kd[4 * j] = t4.x; kd[4 * j + 1] = t4.y; kd[4 * j + 2] = t4.z; kd[4 * j + 3] = t4.w; } }
            else { const v4u* kp = (const v4u*)(Kb + (srow + (key - 1024)) * DM + h * 128 + c * 64);
#pragma unroll
                for (int j = 0; j < 8; ++j) { const v4u t4 = kp[j]; kd[8 * j] = bflo(t4.x); kd[8 * j + 1] = bfhi(t4.x); kd[8 * j + 2] = bflo(t4.y); kd[8 * j + 3] = bfhi(t4.y);
                    kd[8 * j + 4] = bflo(t4.z); kd[8 * j + 5] = bfhi(t4.z); kd[8 * j + 6] = bflo(t4.w); kd[8 * j + 7] = bfhi(t4.w); } }
#pragma unroll
            for (int qq = 0; qq < NQ; ++qq) { const LAS f32x4* qp = (const LAS f32x4*)(Qs + c * (NQ * 64) + qq * 64); float a = 0.f;
#pragma unroll
                for (int j = 0; j < 16; ++j) { const f32x4 q4 = qp[j]; a += (kd[4 * j] * q4.x + kd[4 * j + 1] * q4.y) + (kd[4 * j + 2] * q4.z + kd[4 * j + 3] * q4.w); }
                s[qq] = a; }
#pragma unroll
            for (int qq = 0; qq < NQ; ++qq) SC[qq * SCP + key] = s[qq];
        }
        __syncthreads();
        { LAS float* row = SC + wid * SCP;
            float mx = -INFINITY; for (int key = lane; key < 1040; key += 64) mx = fmaxf(mx, row[key]);
            mx = wave_max(mx);
            float sm = 0.f; for (int key = lane; key < 1040; key += 64) { const float p = exp2f(row[key] - mx); row[key] = p; sm += p; }
            sm = wave_sum(sm); const float inv = 1.0f / sm;
            for (int key = lane; key < 1040; key += 64) row[key] *= inv; }
        __syncthreads();
        { const int e = tid & 127, kq = wid >> 1; float acc[NQ];
#pragma unroll
          for (int qq = 0; qq < NQ; ++qq) acc[qq] = 0.f;
          for (int key = kq * 256; key < kq * 256 + 256; key += 16) {
              float v[16];
#pragma unroll
              for (int u = 0; u < 16; ++u) v[u] = cv[(((size_t)b * 1024 + key + u) * 8 + h) * 128 + e];
#pragma unroll
              for (int qq = 0; qq < NQ; ++qq) {
#pragma unroll
                  for (int u4 = 0; u4 < 4; ++u4) { const f32x4 p4 = *(const LAS f32x4*)(SC + qq * SCP + key + 4 * u4); acc[qq] += (p4.x * v[4 * u4] + p4.y * v[4 * u4 + 1]) + (p4.z * v[4 * u4 + 2] + p4.w * v[4 * u4 + 3]); } } }
          { const int key = 1024 + 4 * kq; float v[4];
#pragma unroll
              for (int u = 0; u < 4; ++u) v[u] = bf2f(Vb[(srow + (key + u - 1024)) * DM + h * 128 + e]);
#pragma unroll
              for (int qq = 0; qq < NQ; ++qq) { const f32x4 p4 = *(const LAS f32x4*)(SC + qq * SCP + key); acc[qq] += (p4.x * v[0] + p4.y * v[1]) + (p4.z * v[2] + p4.w * v[3]); } }
#pragma unroll
          for (int qq = 0; qq < NQ; ++qq) OA[(kq * NQ + qq) * 128 + e] = acc[qq]; }
        __syncthreads();
        { const int qq = wid, e0 = lane * 2; float v[2];
#pragma unroll
          for (int j = 0; j < 2; ++j) v[j] = (OA[(0 * NQ + qq) * 128 + e0 + j] + OA[(1 * NQ + qq) * 128 + e0 + j]) + (OA[(2 * NQ + qq) * 128 + e0 + j] + OA[(3 * NQ + qq) * 128 + e0 + j]);
          if (c == 0) { O0[qq * 128 + e0] = v[0]; O0[qq * 128 + e0 + 1] = v[1]; }
          else { const float o0 = O0[qq * 128 + e0] - lam * v[0], o1 = O0[qq * 128 + e0 + 1] - lam * v[1];
              const float s = wave_sum(o0 * o0 + o1 * o1);
              const float r = rsqrtf(s * (1.f / 128.f) + EPS) * (1.0f - LAM_INIT);
              *(unsigned*)(OC + (srow + q0 + qq) * DM + h * 128 + e0) = pk2(o0 * r * subg[e0], o1 * r * subg[e0 + 1]); } }
        __syncthreads();
    }
}
}

__global__ void __launch_bounds__(NWAVES * 64, 2) yoco_fwd(Args args) {
    extern __shared__ __attribute__((aligned(16))) unsigned char lds[];
    cg::grid_group grid = cg::this_grid();
#define GRID_SYNC() do { asm volatile("s_waitcnt vmcnt(0) lgkmcnt(0)" ::: "memory"); __syncthreads(); \
        if (threadIdx.x == 0) { __builtin_amdgcn_fence(__ATOMIC_RELEASE, "agent"); asm volatile("s_waitcnt vmcnt(0)" ::: "memory"); \
            __hip_atomic_fetch_add(bar_ctr, 1u, __ATOMIC_RELAXED, __HIP_MEMORY_SCOPE_AGENT); bar_target += gridDim.x; \
            while (__hip_atomic_load(bar_ctr, __ATOMIC_RELAXED, __HIP_MEMORY_SCOPE_AGENT) < bar_target) __builtin_amdgcn_s_sleep(8); \
            __builtin_amdgcn_fence(__ATOMIC_ACQUIRE, "agent"); asm volatile("s_waitcnt vmcnt(0)" ::: "memory"); } \
        __syncthreads(); } while (0)
    unsigned* bar_ctr = (unsigned*)args.ws; unsigned bar_target = 0;
    grid.sync();
    Frame F;
    F.lds = (LAS unsigned char*)lds;
#define REFRESH() do { int t_ = threadIdx.x; asm volatile("" : "+v"(t_)); F.tid = t_; F.lane = t_ & 63; F.wave = __builtin_amdgcn_readfirstlane(t_ >> 6); } while (0)
    REFRESH();
    F.G = gridDim.x; { const int bx = blockIdx.x; F.vcu = (F.G % 8 == 0) ? (bx % 8) * (F.G / 8) + bx / 8 : bx; }
    unsigned char* ws = args.ws; float* out = args.out;
    const float* x_prompt = args.in[0]; const float* x_sample = args.in[1]; const float* cache_k = args.in[2]; const float* cache_v = args.in[3]; const float* state_hgrn = args.in[4];
    const float* norm_g = args.in[5]; const float* w_hgrn_in = args.in[6]; const float* lb_logits = args.in[7]; const float* onorm_g = args.in[8]; const float* w_hgrn_out = args.in[9];
    const float* kv_norm_g = args.in[10]; const float* w_kv = args.in[11]; const float* w_dq = args.in[12]; const float* diff_lambda = args.in[13]; const float* subln_g = args.in[14];
    const float* w_do = args.in[15]; const float* w_up = args.in[16]; const float* w_down = args.in[17];
    float* OML = (float*)(ws + WS_OML);
    bf16* Wt_in = (bf16*)(ws + WS_WIN); bf16* Wt_ho = (bf16*)(ws + WS_WHO); bf16* Wt_up0 = (bf16*)(ws + WS_WUP0); bf16* Wt_dn0 = (bf16*)(ws + WS_WDN0);
    bf16* Wt_qkv = (bf16*)(ws + WS_WQKV); bf16* Wt_do = (bf16*)(ws + WS_WDO); bf16* Wt_up1 = (bf16*)(ws + WS_WUP1); bf16* Wt_dn1 = (bf16*)(ws + WS_WDN1);
    bf16* XN = (bf16*)(ws + WS_XN); bf16* MB = (bf16*)(ws + WS_MB); bf16* R0 = (bf16*)(ws + WS_R0);
    bf16* QB = (bf16*)(ws + WS_Q); bf16* KB = (bf16*)(ws + WS_K); bf16* VB = (bf16*)(ws + WS_V); bf16* O1 = (bf16*)(ws + WS_O1); bf16* O2 = (bf16*)(ws + WS_O2); bf16* OC = QB; float* RS = (float*)(ws + WS_RS); float* PACC = (float*)(ws + WS_PACC);
    const int NGW = F.G * NWAVES;

    {
        const int gw = F.vcu * NWAVES + F.wave;
        LAS float* scr = (LAS float*)(F.lds + RING_OFF + F.wave * 16384);
        constexpr int I_SQ = (DM / 64) * (DM / 32), I_UP = (DM / 64) * (FF / 32), I_DN = (FF / 64) * (DM / 32), I_KV = (DM / 64) * (2 * DM / 32);
        constexpr int NITEMS = I_UP   + I_SQ   + 2 * I_UP + 2 * I_DN + I_SQ   + I_KV + I_SQ  ;
#define W_ITEM(it_) do { int r = (it_); \
            if (r < I_UP) { p0_transpose_item(w_hgrn_in, norm_g + 0 * DM, DM, FF, Wt_in, 0, scr, r, F.lane); break; } r -= I_UP; \
            if (r < I_SQ) { p0_transpose_item(w_hgrn_out, nullptr, DM, DM, Wt_ho, 0, scr, r, F.lane); break; } r -= I_SQ; \
            if (r < I_UP) { p0_transpose_item(w_up, norm_g + 2 * DM, DM, FF, Wt_up0, 0, scr, r, F.lane); break; } r -= I_UP; \
            if (r < I_UP) { p0_transpose_item(w_up + (size_t)DM * FF, norm_g + 6 * DM, DM, FF, Wt_up1, 0, scr, r, F.lane); break; } r -= I_UP; \
            if (r < I_DN) { p0_transpose_item(w_down, nullptr, FF, DM, Wt_dn0, 0, scr, r, F.lane); break; } r -= I_DN; \
            if (r < I_DN) { p0_transpose_item(w_down + (size_t)FF * DM, nullptr, FF, DM, Wt_dn1, 0, scr, r, F.lane); break; } r -= I_DN; \
            if (r < I_SQ) { p0_transpose_item(w_dq, norm_g + 4 * DM, DM, DM, Wt_qkv, 0, scr, r, F.lane); break; } r -= I_SQ; \
            if (r < I_KV) { p0_transpose_item(w_kv, kv_norm_g, DM, 2 * DM, Wt_qkv, DM, scr, r, F.lane); break; } r -= I_KV; \
            p0_transpose_item(w_do, nullptr, DM, DM, Wt_do, 0, scr, r, F.lane); } while (0)
        for (int it = gw; it < ((F.G > 192) ? I_UP : NITEMS); it += NGW) W_ITEM(it);
        if (blockIdx.x == 0) { for (int c = F.tid; c < DM; c += NWAVES * 64) { const float l0 = lb_logits[c], l1 = lb_logits[DM + c]; OML[c] = 1.0f / (1.0f + __expf(l0 - l1)); } }
        for (int m = gw; m < M; m += NGW) rms_row_to_bf16(m < NP ? x_prompt + (size_t)m * DM : x_sample + (size_t)(m - NP) * DM, XN + (size_t)m * DM, RS + m, F.lane);
    }
    GRID_SYNC(); if (STOP_AFTER == 0) return;

    {
        pg8::Gemm g{XN, Wt_in, M, FF, DM}; pg8::StaticOrder S; S.init(M, FF, F.G, (int)blockIdx.x);
        pg8::EpiAct<2> E{R0, FF, OML, nullptr, nullptr, 0, 1.f};
        pg8::gemm_phase<pg8::EpiAct<2>, pg8::StaticOrder, PG8_ALIGN, PG8_SP2>(F.lds + RING_OFF, g, S, E);
    }
    GRID_SYNC(); if (STOP_AFTER == 1) { REFRESH(); for (int row = F.vcu * NWAVES + F.wave; row < NP; row += NGW) for (int c = F.lane; c < DM; c += 64) { out[(size_t)row * DM + c] = bf2f(R0[(size_t)row * FF + c]); out[O_KP + (size_t)row * DM + c] = bf2f(R0[(size_t)row * FF + 3072 + c]); } return; }

    if ((int)blockIdx.x >= 192) {
        REFRESH();
        LAS float* scr = (LAS float*)(F.lds + RING_OFF + F.wave * 16384);
        constexpr int I_SQ = (DM / 64) * (DM / 32), I_UP = (DM / 64) * (FF / 32), I_DN = (FF / 64) * (DM / 32), I_KV = (DM / 64) * (2 * DM / 32);
        constexpr int NITEMS = I_UP + I_SQ + 2 * I_UP + 2 * I_DN + I_SQ + I_KV + I_SQ;
        const int nidle = ((int)F.G - 192) * NWAVES;
        for (int it = I_UP + ((int)blockIdx.x - 192) * NWAVES + F.wave; it < NITEMS; it += nidle) W_ITEM(it);
    }
    for (int it = blockIdx.x; it < 64 + 128; it += F.G) {
        if (it < 64) { const int b = it >> 3, h = it & 7;
            hg::hgrn_item<64>(F.lds + RING_OFF, R0, O2, nullptr, out + O_STP + (size_t)it * 16384, (long)b * 8192, 128, h, onorm_g); }
        else { const int is = it - 64, b = is >> 3, h = is & 7;
            hg::hgrn_item<16>(F.lds + RING_OFF, R0, O2, state_hgrn + (size_t)is * 16384, out + O_STS + (size_t)is * 16384, (long)NP + b * 16, 1, h, onorm_g); }
    }
    GRID_SYNC(); if (STOP_AFTER == 2) { REFRESH(); for (int row = F.vcu * NWAVES + F.wave; row < M; row += NGW) for (int c = F.lane; c < DM; c += 64) out[(size_t)row * DM + c] = bf2f(XN[(size_t)row * DM + c]) - bf2f(MB[(size_t)row * DM + c]);
        for (size_t i = (size_t)blockIdx.x * 512 + F.tid; i < (size_t)192 * 16384; i += (size_t)F.G * 512) { const float a = (i < (size_t)64 * 16384) ? out[O_STP + i] : out[O_STS + i - (size_t)64 * 16384]; out[(size_t)1024 * DM + i] = a - ((const float*)(ws + 900 * MiB))[i]; }
        return; }

    {
        pg8::Gemm g{O2, Wt_ho, M, DM, DM}; pg8::StaticOrder S; S.init(M, DM, F.G, (int)blockIdx.x, DM, SPLK);
        pg8::EpiAct<0> E{MB, DM, nullptr, nullptr, nullptr, 0, 1.f, PACC};
        pg8::gemm_phase<pg8::EpiAct<0>, pg8::StaticOrder, PG8_ALIGN, PG8_SP2>(F.lds + RING_OFF, g, S, E);
    }
    GRID_SYNC(); if (STOP_AFTER == 3) { REFRESH(); for (int row = F.vcu * NWAVES + F.wave; row < M; row += NGW) for (int c = F.lane; c < DM; c += 64) out[(size_t)row * DM + c] = bf2f(MB[(size_t)row * DM + c]); return; }
    REFRESH(); norm_phase<false>(F, MB, PACC, norm_g + 1 * DM, RS, out, XN);
    GRID_SYNC(); if (STOP_AFTER == 4) return;
    {
        pg8::Gemm g{XN, Wt_up0, M, FF, DM}; pg8::StaticOrder S; S.init(M, FF, F.G, (int)blockIdx.x);
        pg8::EpiAct<1> E{R0, FF, nullptr, nullptr, nullptr, 0, 1.f};
        pg8::gemm_phase<pg8::EpiAct<1>, pg8::StaticOrder, PG8_ALIGN, PG8_SP2>(F.lds + RING_OFF, g, S, E);
    }
    GRID_SYNC(); if (STOP_AFTER == 5) return;
    {
        pg8::Gemm g{R0, Wt_dn0, M, DM, FF}; pg8::StaticOrder S; S.init(M, DM, F.G, (int)blockIdx.x, FF, SPLK);
        pg8::EpiAct<0> E{MB, DM, nullptr, nullptr, nullptr, 0, 1.f, PACC};
        pg8::gemm_phase<pg8::EpiAct<0>, pg8::StaticOrder, PG8_ALIGN, PG8_SP2>(F.lds + RING_OFF, g, S, E);
    }
    GRID_SYNC(); if (STOP_AFTER == 6) return;
    REFRESH(); norm_phase<false>(F, MB, PACC, norm_g + 3 * DM, RS, out, XN);
    GRID_SYNC(); if (STOP_AFTER == 7) return;
    {
        pg8::Gemm g{XN, Wt_qkv, M, 3 * DM, DM}; pg8::StaticOrder S; S.init(M, 3 * DM, F.G, (int)blockIdx.x);
        pg8::EpiAct<3> E{QB, DM, nullptr, out + O_KP, out + O_KS, (size_t)(WS_K - WS_Q) / 2, attn_body::C2};
        pg8::gemm_phase<pg8::EpiAct<3>, pg8::StaticOrder, PG8_ALIGN, PG8_SP2>(F.lds + RING_OFF, g, S, E);
    }
    GRID_SYNC(); if (STOP_AFTER == 8) return;
    {
        const attn_body::AttnTensors AT{(const attn_body::bf16*)QB, (const attn_body::bf16*)KB, (const attn_body::bf16*)VB, (attn_body::bf16*)O1, (attn_body::bf16*)O2};
        const attn_body::StaticOrder S((int)F.G, (int)blockIdx.x);
        attn_body::attn_phase<attn_body::StaticOrder>((char*)lds + RING_OFF, AT, S);
        asm volatile("s_waitcnt vmcnt(0) lgkmcnt(0)" ::: "memory"); __syncthreads();
        REFRESH(); const float lam = compute_lam(diff_lambda, F.lane);
        for (int it = F.vcu; it < 256; it += F.G) sa::item(F.lds + RING_OFF, it, QB, KB, VB, cache_k, cache_v, OC, lam, subln_g);
    }
    GRID_SYNC(); if (STOP_AFTER == 9) return;
    REFRESH(); combine_phase(F, O1, O2, diff_lambda, subln_g, OC);
    GRID_SYNC(); if (STOP_AFTER == 10) return;
    {
        pg8::Gemm g{OC, Wt_do, M, DM, DM}; pg8::StaticOrder S; S.init(M, DM, F.G, (int)blockIdx.x, DM, SPLK);
        pg8::EpiAct<0> E{MB, DM, nullptr, nullptr, nullptr, 0, 1.f, PACC};
        pg8::gemm_phase<pg8::EpiAct<0>, pg8::StaticOrder, PG8_ALIGN, PG8_SP2>(F.lds + RING_OFF, g, S, E);
    }
    GRID_SYNC(); if (STOP_AFTER == 11) return;
    REFRESH(); norm_phase<false>(F, MB, PACC, norm_g + 5 * DM, RS, out, XN);
    GRID_SYNC(); if (STOP_AFTER == 12) return;
    {
        pg8::Gemm g{XN, Wt_up1, M, FF, DM}; pg8::StaticOrder S; S.init(M, FF, F.G, (int)blockIdx.x);
        pg8::EpiAct<1> E{R0, FF, nullptr, nullptr, nullptr, 0, 1.f};
        pg8::gemm_phase<pg8::EpiAct<1>, pg8::StaticOrder, PG8_ALIGN, PG8_SP2>(F.lds + RING_OFF, g, S, E);
    }
    GRID_SYNC(); if (STOP_AFTER == 13) return;
    {
        pg8::Gemm g{R0, Wt_dn1, M, DM, FF}; pg8::StaticOrder S; S.init(M, DM, F.G, (int)blockIdx.x, FF, SPLK);
        pg8::EpiAct<0> E{MB, DM, nullptr, nullptr, nullptr, 0, 1.f, PACC};
        pg8::gemm_phase<pg8::EpiAct<0>, pg8::StaticOrder, PG8_ALIGN, PG8_SP2>(F.lds + RING_OFF, g, S, E);
    }
    GRID_SYNC(); if (STOP_AFTER == 14) return;
    REFRESH(); norm_phase<true>(F, MB, PACC, norm_g + 7 * DM, RS, out, XN);
}

extern "C" void kernel_launch(void* const* d_in, const int* in_sizes, int n_in, void* d_out, int out_size, void* d_ws, size_t ws_size, hipStream_t stream) {
    static int grid = 0;
    if (grid == 0) {
        if (n_in != 18 || in_sizes[0] != NP * DM || (size_t)out_size != O_END || ws_size < WS_END) {
            fprintf(stderr, "kernel_launch: shape mismatch: n_in %d in0 %d out %d ws %zu (need out %zu ws %zu); nothing launched\n", n_in, n_in > 0 ? in_sizes[0] : -1, out_size, ws_size, (size_t)O_END, (size_t)WS_END); grid = -1; return; }
        int dev = 0, cus = 0, per_cu = 0;
        if (hipGetDevice(&dev) != hipSuccess || hipDeviceGetAttribute(&cus, hipDeviceAttributeMultiprocessorCount, dev) != hipSuccess) { fprintf(stderr, "kernel_launch: device query failed\n"); grid = -1; return; }
        if (hipFuncSetAttribute((const void*)yoco_fwd, hipFuncAttributeMaxDynamicSharedMemorySize, LDS_BYTES) != hipSuccess) { fprintf(stderr, "kernel_launch: hipFuncSetAttribute failed\n"); grid = -1; return; }
        if (hipOccupancyMaxActiveBlocksPerMultiprocessor(&per_cu, (const void*)yoco_fwd, NWAVES * 64, LDS_BYTES) != hipSuccess || per_cu < 1) { fprintf(stderr, "kernel_launch: occupancy query says %d\n", per_cu); per_cu = 1; }
        (void)hipGetLastError();
        grid = cus;
    }
    if (grid < 0) return;
    if (hipMemsetAsync(d_ws, 0, 256, stream) != hipSuccess) { fprintf(stderr, "kernel_launch: memset failed\n"); return; }
    Args a{};
    for (int i = 0; i < 18; ++i) a.in[i] = (const float*)d_in[i];
    a.out = (float*)d_out; a.ws = (unsigned char*)d_ws;
    void* kargs[] = {&a};
    hipError_t e = hipLaunchCooperativeKernel((const void*)yoco_fwd, dim3(grid), dim3(NWAVES * 64), kargs, LDS_BYTES, stream);
    if (e != hipSuccess) fprintf(stderr, "kernel_launch: cooperative launch failed: %s (grid %d)\n", hipGetErrorString(e), grid);
}
```

```cpp
#include <hip/hip_runtime.h>
#include <cstdio>
#include <cstdint>
namespace pg8 {
#define PG8_LAS __attribute__((address_space(3)))
typedef unsigned short bf16_t;
typedef short bf16x8 __attribute__((ext_vector_type(8)));
typedef float f32x4 __attribute__((ext_vector_type(4)));
typedef unsigned u32x4 __attribute__((ext_vector_type(4)));
constexpr int BM = 256, BK = 64, HALF = 128, HTB = HALF * BK * 2  , STAGE_BYTES = 8 * HTB, NXCD = 8, WGM = 8;

__host__ __device__ __forceinline__ int lds_byte(int r, int c) { const int st = (r >> 4) * 2 + (c >> 5), rr = r & 15, cc = c & 31, ob = rr * 64 + cc * 2; return st * 1024 + (ob ^ (((ob >> 9) & 1) << 5)); }
__host__ __device__ __forceinline__ void stage_rc(int b, int& R, int& C) { const int st = b / 1024, sb = b % 1024, swz = sb ^ (((sb >> 9) & 1) << 5); R = (st >> 1) * 16 + swz / 64; C = (st & 1) * 32 + (swz % 64) / 2; }
__host__ __device__ __forceinline__ int perm32(int rho) { const int n = rho >> 4, i = rho & 15; return 8 * (i >> 2) + 4 * n + (i & 3); }

struct Unit { int pm, pn; };
struct Gemm { const bf16_t* A; const bf16_t* Bt; int M, N, K; };

struct StaticOrder {
    int nM, nN, nwg, G, c, spl, nfull, ntk;
    __host__ __device__ __forceinline__ void init(int M, int N, int G_, int c_, int K = 0, int spl_ = 1) { nM = M / BM; nN = N / BM; G = G_; c = c_; spl = spl_; ntk = K / BK;
        if (spl > 1) { nM -= 1; nfull = nM * nN; nwg = nfull + nN * spl; } else { nfull = nwg = nM * nN; } }
    __host__ __device__ __forceinline__ bool next(int i, Unit& u) const {
        const long L = (long)i * G + c; if (L >= nwg) return false;
        if (L >= nfull) { const int j = (int)(L - nfull); u.pm = nM; u.pn = (j % nN) | ((j / nN + 1) << 8); return true; }
        int wgid = (int)L; { const int q = nfull / NXCD, r = nfull % NXCD, xcd = wgid % NXCD, off = wgid / NXCD; wgid = (xcd < r ? xcd * (q + 1) : r * (q + 1) + (xcd - r) * q) + off; }
        const int nig = WGM * nN, gid = wgid / nig, fm = gid * WGM, gsz = (nM - fm) < WGM ? (nM - fm) : WGM;
        u.pm = fm + ((wgid % nig) % gsz); u.pn = (wgid % nig) / gsz; return true;
    }
    __device__ __forceinline__ void a_ready(const Unit&) const {}
    __device__ __forceinline__ void done(const Unit&) const {}
};
typedef float cvt_f32x2_t __attribute__((ext_vector_type(2))); typedef __bf16 cvt_bf16x2_t __attribute__((ext_vector_type(2)));
__device__ __forceinline__ unsigned cvt_pk_bf16(float lo, float hi) { cvt_f32x2_t v = {lo, hi}; cvt_bf16x2_t b = __builtin_convertvector(v, cvt_bf16x2_t); return __builtin_bit_cast(unsigned, b); }
typedef float f32x2 __attribute__((ext_vector_type(2)));

typedef unsigned u32x4 __attribute__((ext_vector_type(4)));
__device__ __forceinline__ float fast_rcp(float x) { return __builtin_amdgcn_rcpf(x); }
__device__ __forceinline__ float silu_f(float x) { return x * fast_rcp(1.0f + __expf(-x)); }
template <int MODE> struct EpiAct {
    static constexpr bool PERM = true, AFTER_DRAIN = false;
    bf16_t* O; int ldc; const float* aux; float* kvp; float* kvs; size_t split_stride; float scale0; float* pacc = nullptr;
    __device__ __forceinline__ void operator()(const f32x4 (&acc)[2][2][4][2], const Unit& u, int wr, int wc, int fr, int fq) const {
        const int row0 = u.pm * BM + wr * 64 + fr;
        const int upn = u.pn & 255, upart = u.pn >> 8; int colt = upn * BM; bf16_t* base = O; float* fbase = nullptr; int type = 0;
        if (MODE == 2) type = upn >> 2;
        if (MODE == 3) { type = upn >> 2; colt -= type * 1024; base = O + (size_t)type * split_stride;
            if (type > 0) { fbase = (u.pm < 256) ? kvp + (size_t)(type - 1) * (65536u * 1024u) : (kvs + (size_t)(type - 1) * (256u * 1024u)) - (size_t)65536 * 1024; } }
        const int col0 = colt + wc * 32 + 8 * fq;
        f32x4 av[2][2];
        if (MODE == 2) {
#pragma unroll
            for (int bj = 0; bj < 2; ++bj)
#pragma unroll
                for (int n = 0; n < 2; ++n) av[bj][n] = (type == 1) ? *(const f32x4*)(aux + ((col0 + bj * HALF + 4 * n) & 1023)) : (f32x4){0.f, 0.f, 0.f, 0.f};
        }
#pragma unroll
        for (int ai = 0; ai < 2; ++ai)
#pragma unroll
            for (int m = 0; m < 4; ++m) { const size_t roff = (size_t)(row0 + ai * HALF + m * 16) * ldc + col0; bf16_t* rowp = base + roff;
#pragma unroll
                for (int bj = 0; bj < 2; ++bj) { f32x4 v0 = acc[ai][bj][m][0], v1 = acc[ai][bj][m][1];
                    if (MODE == 0 && upart != 0) { float* fp = pacc + (size_t)(upart - 1) * (256u * 1024u) + (size_t)(wr * 64 + fr + ai * HALF + m * 16) * ldc + col0 + bj * HALF; *(f32x4*)fp = v0; *(f32x4*)(fp + 4) = v1; continue; }
                    if (MODE == 1) {
#pragma unroll
                        for (int e = 0; e < 4; ++e) { const float a = fmaxf(v0[e], 0.f), b = fmaxf(v1[e], 0.f); v0[e] = a * a; v1[e] = b * b; } }
                    if (MODE == 2) {
                        if (type == 0 || type == 3) {
#pragma unroll
                            for (int e = 0; e < 4; ++e) { v0[e] = silu_f(v0[e]); v1[e] = silu_f(v1[e]); } }
                        else if (type == 1) {
#pragma unroll
                            for (int e = 0; e < 4; ++e) { v0[e] = av[bj][0][e] * fast_rcp(1.0f + __expf(v0[e])); v1[e] = av[bj][1][e] * fast_rcp(1.0f + __expf(v1[e])); } }
                    }
                    if (MODE == 3) {
                        if (type == 0) { v0 = v0 * scale0; v1 = v1 * scale0; }
                        else { float* fp = fbase + roff + bj * HALF; *(f32x4*)fp = v0; *(f32x4*)(fp + 4) = v1; }
                    }
                    u32x4 w; w.x = cvt_pk_bf16(v0[0], v0[1]); w.y = cvt_pk_bf16(v0[2], v0[3]); w.z = cvt_pk_bf16(v1[0], v1[1]); w.w = cvt_pk_bf16(v1[2], v1[3]);
                    *(u32x4*)(rowp + bj * HALF) = w; } }
    }
};

template <class Epi, class Sched, bool ALIGN_EPI = false, bool SP2 = false>
__device__ __forceinline__ void gemm_phase(PG8_LAS unsigned char* lds, const Gemm g, const Sched& S, const Epi& E) {
    int tid_ = threadIdx.x; asm volatile("" : "+v"(tid_));
    const int tid = tid_, wid = __builtin_amdgcn_readfirstlane(tid >> 6), lane = tid & 63, wr = wid >> 2, wc = wid & 3, fr = lane & 15, fq = lane >> 4;
    const int K = g.K, nt = K / BK;
    unsigned voffA[2], voffB[2];
#pragma unroll
    for (int i = 0; i < 2; ++i) { int R, C; stage_rc(tid * 16 + i * 8192, R, C); const int Rb = Epi::PERM ? ((R & ~31) + perm32(R & 31)) : R;
        voffA[i] = (unsigned)(R * K + C) * 2u; voffB[i] = (unsigned)(Rb * K + C) * 2u; }
    const size_t kstep = (size_t)(BK * 2);
    const size_t hstep = (size_t)HALF * K * 2;
    const size_t tstep = 2 * hstep;
    const unsigned ldsw = (unsigned)wid * 1024u;
    const int aoff = lds_byte(wr * 64 + fr, fq * 8), boff = lds_byte(wc * 32 + fr, fq * 8);
#define PG8_SA(b, h) (((b) * 2 + (h)) * HTB)
#define PG8_SB(b, h) ((4 + (b) * 2 + (h)) * HTB)
#define PG8_STAGE(bufoff, gbase, voff) do { _Pragma("unroll") for (int _i = 0; _i < 2; ++_i) \
        __builtin_amdgcn_global_load_lds((const unsigned*)((const char*)(gbase) + (voff)[_i]), (PG8_LAS unsigned*)(lds + (bufoff) + ldsw + _i * 8192), 16, 0, 0); } while (0)
#define PG8_LDA(dst, b, h) do { _Pragma("unroll") for (int m = 0; m < 4; ++m) _Pragma("unroll") for (int k = 0; k < 2; ++k) dst[m][k] = *(const PG8_LAS bf16x8*)(lds + PG8_SA(b, h) + aoff + m * 2048 + k * 1024); } while (0)
#define PG8_LDB(dst, b, h) do { _Pragma("unroll") for (int n = 0; n < 2; ++n) _Pragma("unroll") for (int k = 0; k < 2; ++k) dst[n][k] = *(const PG8_LAS bf16x8*)(lds + PG8_SB(b, h) + boff + n * 2048 + k * 1024); } while (0)
#define PG8_MMA(ai, bj, At, Bt) do { __builtin_amdgcn_s_setprio(1); _Pragma("unroll") for (int m = 0; m < 4; ++m) _Pragma("unroll") for (int n = 0; n < 2; ++n) _Pragma("unroll") for (int k = 0; k < 2; ++k) \
        acc[ai][bj][m][n] = __builtin_amdgcn_mfma_f32_16x16x32_bf16(Bt[n][k], At[m][k], acc[ai][bj][m][n], 0, 0, 0); __builtin_amdgcn_s_setprio(0); } while (0)
#define PG8_WAIT_V(n) asm volatile("s_waitcnt vmcnt(" #n ")" ::: "memory")
#define PG8_WAIT_L(n) asm volatile("s_waitcnt lgkmcnt(" #n ")" ::: "memory")
#define PG8_BAR __builtin_amdgcn_s_barrier()
#define PG8_SCHED __builtin_amdgcn_sched_barrier(0)
    Unit cur, nxt; int ui = 0;
    if (!S.next(0, cur)) return;
    const int nktp = S.spl > 1 ? S.ntk / S.spl : nt;
#define PG8_NT(u) (((u).pn >> 8) ? nktp : nt)
#define PG8_K0(u) ((size_t)(((u).pn >> 8) ? (((u).pn >> 8) - 1) * nktp : 0) * kstep)
    int ntc = PG8_NT(cur);
    f32x4 acc[2][2][4][2];
#pragma unroll
    for (int a = 0; a < 2; ++a)
#pragma unroll
        for (int b = 0; b < 2; ++b)
#pragma unroll
            for (int m = 0; m < 4; ++m)
#pragma unroll
                for (int n = 0; n < 2; ++n) acc[a][b][m][n] = (f32x4){0.f, 0.f, 0.f, 0.f};
    bf16x8 At[4][2], B0[2][2], B1[2][2];
    const char* cA = (const char*)g.A + (size_t)cur.pm * tstep + PG8_K0(cur); const char* cB = (const char*)g.Bt + (size_t)(cur.pn & 255) * tstep + PG8_K0(cur);
    S.a_ready(cur);
    if constexpr (SP2) {
        PG8_STAGE(PG8_SB(0, 0), cB, voffB); PG8_STAGE(PG8_SB(0, 1), cB + hstep, voffB); PG8_STAGE(PG8_SA(0, 0), cA, voffA); PG8_STAGE(PG8_SA(0, 1), cA + hstep, voffA);
        if (wr == 1) PG8_BAR;
        PG8_WAIT_V(2); PG8_BAR;
        PG8_STAGE(PG8_SB(1, 0), cB + kstep, voffB); PG8_STAGE(PG8_SA(1, 0), cA + kstep, voffA); PG8_STAGE(PG8_SB(1, 1), cB + hstep + kstep, voffB);
        PG8_WAIT_V(6); PG8_BAR;
    } else {
        PG8_STAGE(PG8_SB(0, 0), cB, voffB); PG8_STAGE(PG8_SA(0, 0), cA, voffA); PG8_STAGE(PG8_SB(0, 1), cB + hstep, voffB); PG8_STAGE(PG8_SA(0, 1), cA + hstep, voffA);
        if (wr == 1) PG8_BAR;
        PG8_WAIT_V(4); PG8_BAR;
        PG8_STAGE(PG8_SB(1, 0), cB + kstep, voffB); PG8_STAGE(PG8_SA(1, 0), cA + kstep, voffA); PG8_STAGE(PG8_SB(1, 1), cB + hstep + kstep, voffB);
        PG8_WAIT_V(6); PG8_BAR;
    }
    for (;;) {
        const bool has_next = S.next(ui + 1, nxt);
        const char* nA = has_next ? (const char*)g.A + (size_t)nxt.pm * tstep + PG8_K0(nxt) : cA; const char* nB = has_next ? (const char*)g.Bt + (size_t)(nxt.pn & 255) * tstep + PG8_K0(nxt) : cB;
        for (int t = 0; t < ntc; t += 2) {
            const bool last = (t == ntc - 2);
            const char* a1 = cA + (size_t)(t + 1) * kstep;
            const char* a2 = last ? nA : cA + (size_t)(t + 2) * kstep; const char* b2 = last ? nB : cB + (size_t)(t + 2) * kstep;
            const char* a3 = a2 + kstep; const char* b3 = b2 + kstep;
            if (last && has_next) S.a_ready(nxt);
            if constexpr (SP2) {
            PG8_LDB(B0, 0, 0); PG8_LDB(B1, 0, 1); PG8_SCHED; PG8_LDA(At, 0, 0); PG8_STAGE(PG8_SA(1, 1), a1 + hstep, voffA);
            PG8_WAIT_V(8); PG8_WAIT_L(0); PG8_BAR; PG8_MMA(0, 0, At, B0); PG8_MMA(0, 1, At, B1); PG8_BAR; PG8_SCHED;
            PG8_LDA(At, 0, 1); PG8_STAGE(PG8_SB(0, 0), b2, voffB); PG8_STAGE(PG8_SB(0, 1), b2 + hstep, voffB); PG8_STAGE(PG8_SA(0, 0), a2, voffA);
            PG8_WAIT_V(8); PG8_WAIT_L(0); PG8_BAR; PG8_MMA(1, 0, At, B0); PG8_MMA(1, 1, At, B1); PG8_BAR; PG8_SCHED;
            PG8_LDB(B0, 1, 0); PG8_LDB(B1, 1, 1); PG8_SCHED; PG8_LDA(At, 1, 0); PG8_STAGE(PG8_SA(0, 1), a2 + hstep, voffA);
            PG8_WAIT_V(8); PG8_WAIT_L(0); PG8_BAR; PG8_MMA(0, 0, At, B0); PG8_MMA(0, 1, At, B1); PG8_BAR; PG8_SCHED;
            PG8_LDA(At, 1, 1); PG8_STAGE(PG8_SB(1, 0), b3, voffB); PG8_STAGE(PG8_SB(1, 1), b3 + hstep, voffB); PG8_STAGE(PG8_SA(1, 0), a3, voffA);
            PG8_WAIT_V(8); PG8_WAIT_L(0); PG8_BAR; PG8_MMA(1, 0, At, B0); PG8_MMA(1, 1, At, B1); PG8_BAR; PG8_SCHED;
            } else {
            PG8_LDB(B0, 0, 0); PG8_SCHED; PG8_LDA(At, 0, 0); PG8_STAGE(PG8_SA(1, 1), a1 + hstep, voffA);
            PG8_WAIT_L(8); PG8_BAR; PG8_WAIT_L(0); PG8_MMA(0, 0, At, B0); PG8_BAR; PG8_SCHED;
            PG8_LDB(B1, 0, 1); PG8_STAGE(PG8_SB(0, 0), b2, voffB);
            PG8_BAR; PG8_WAIT_L(0); PG8_MMA(0, 1, At, B1); PG8_BAR;
            PG8_LDA(At, 0, 1); PG8_STAGE(PG8_SA(0, 0), a2, voffA);
            PG8_BAR; PG8_WAIT_L(0); PG8_MMA(1, 0, At, B0); PG8_BAR; PG8_SCHED;
            PG8_STAGE(PG8_SB(0, 1), b2 + hstep, voffB);
            PG8_WAIT_V(6); PG8_BAR; PG8_MMA(1, 1, At, B1); PG8_BAR;
            PG8_LDB(B0, 1, 0); PG8_SCHED; PG8_LDA(At, 1, 0); PG8_STAGE(PG8_SA(0, 1), a2 + hstep, voffA);
            PG8_WAIT_L(8); PG8_BAR; PG8_WAIT_L(0); PG8_MMA(0, 0, At, B0); PG8_BAR; PG8_SCHED;
            PG8_LDB(B1, 1, 1); PG8_STAGE(PG8_SB(1, 0), b3, voffB);
            PG8_BAR; PG8_WAIT_L(0); PG8_MMA(0, 1, At, B1); PG8_BAR;
            PG8_LDA(At, 1, 1); PG8_STAGE(PG8_SA(1, 0), a3, voffA);
            PG8_BAR; PG8_WAIT_L(0); PG8_MMA(1, 0, At, B0); PG8_BAR; PG8_SCHED;
            PG8_STAGE(PG8_SB(1, 1), b3 + hstep, voffB);
            PG8_WAIT_V(6); PG8_BAR; PG8_MMA(1, 1, At, B1); PG8_BAR;
            }
        }
        if constexpr (ALIGN_EPI) { if (wr == 0) PG8_BAR; }
        if constexpr (!Epi::AFTER_DRAIN) { E(acc, cur, wr, wc, fr, fq); S.done(cur); }
        if (!has_next) break;
#pragma unroll
        for (int a = 0; a < 2; ++a)
#pragma unroll
            for (int b = 0; b < 2; ++b)
#pragma unroll
                for (int m = 0; m < 4; ++m)
#pragma unroll
                    for (int n = 0; n < 2; ++n) acc[a][b][m][n] = (f32x4){0.f, 0.f, 0.f, 0.f};
        cur = nxt; cA = nA; cB = nB; ++ui; ntc = PG8_NT(cur);
        if constexpr (ALIGN_EPI) { if (wr == 1) PG8_BAR; }
    }
    PG8_WAIT_V(0);
    if constexpr (!ALIGN_EPI) { if (wr == 0) PG8_BAR; }
    PG8_BAR;
    if constexpr (Epi::AFTER_DRAIN) { E.fused(acc, cur, wr, wc, fr, fq, lds, wid, lane); S.done(cur); }
#undef PG8_SA
#undef PG8_SB
#undef PG8_STAGE
#undef PG8_LDA
#undef PG8_LDB
#undef PG8_MMA
#undef PG8_WAIT_V
#undef PG8_WAIT_L
#undef PG8_BAR
#undef PG8_SCHED
#undef PG8_NT
#undef PG8_K0
}
}
#define PG8_SP2 true
#define PG8_ALIGN true
#include <hip/hip_bf16.h>
#include <cmath>
namespace attn_body {
using bf16=__hip_bfloat16;
using bf16x8=__attribute__((ext_vector_type(8)))short;
using s16x4=__attribute__((ext_vector_type(4)))short;
using f32x16=__attribute__((ext_vector_type(16)))float;
using u32x4=__attribute__((ext_vector_type(4)))unsigned;
constexpr int BATCH=8,NHEAD=16,SEQ=8192,D=64,DM=NHEAD*D;
constexpr int NW=8,QBLK=32,QB=QBLK*NW,KVBLK=64,NQB=SEQ/QB;
constexpr int ATTN_PITCH=DM, ATTN_UNIT_ROWS=QB;
__device__ __forceinline__ int crow(int r,int hi){return (r&3)+8*(r>>2)+4*hi;}
#define SBAR() __builtin_amdgcn_sched_barrier(0)
__device__ __forceinline__ void cmask(f32x16&p0,f32x16&p1,int jb,int qrel,int hi){
  const float NEG=-INFINITY; (void)hi;
  if(jb>(qrel>>6)){
  #pragma unroll
  for(int r=0;r<16;++r){p0[r]=NEG;p1[r]=NEG;} }
}

constexpr int NSLOT=3, SLOTB=8192;
constexpr int LDS_K=0, LDS_V=NSLOT*SLOTB, LDS_WS=2*NSLOT*SLOTB, LDS_OST=LDS_WS+NW*64*4, LDS_BYTES=LDS_OST+NW*4096;
constexpr float C2=0.125f*1.4426950408889634f;
__device__ __forceinline__ void glds16(const void*gsrc,unsigned lds_dst){unsigned keep;
  asm volatile("s_mov_b32 %0, m0\n\ts_mov_b32 m0, %2\n\ts_nop 0\n\tglobal_load_lds_dwordx4 %1, off\n\ts_mov_b32 m0, %0":"=&s"(keep):"v"(gsrc),"s"(lds_dst):"memory");}
__device__ __forceinline__ float max3f(float a,float b,float c){float r;asm("v_max3_f32 %0, %1, %2, %3":"=v"(r):"v"(a),"v"(b),"v"(c));return r;}
__device__ __forceinline__ float max2f(float a,float b){float r;asm("v_max_f32_e32 %0, %1, %2":"=v"(r):"v"(a),"v"(b));return r;}
__device__ __forceinline__ float fadd_s(float a,float b){float r;asm("v_add_f32_e32 %0, %1, %2":"=v"(r):"v"(a),"v"(b));return r;}
__device__ __forceinline__ float fsub_s(float a,float b){float r;asm("v_sub_f32_e32 %0, %1, %2":"=v"(r):"v"(a),"v"(b));return r;}
typedef float f32x2_t __attribute__((ext_vector_type(2))); typedef __bf16 bf16x2_t __attribute__((ext_vector_type(2)));
__device__ __forceinline__ unsigned cvtpk_s(float lo,float hi){f32x2_t v={lo,hi};bf16x2_t b=__builtin_convertvector(v,bf16x2_t);return __builtin_bit_cast(unsigned,b);}
#define WAIT_BAR(N) asm volatile("s_waitcnt vmcnt(" #N ") lgkmcnt(0)\n\ts_barrier":::"memory")

__device__ __forceinline__ void qkt(f32x16&p0,f32x16&p1,const char*Kslot,const bf16x8*qr,const f32x16&negm,int r32,int hi){
  const char*kb=Kslot+hi*1024+r32*16;
  #pragma unroll
  for(int d0=0;d0<4;++d0){
    const bf16x8 b0=*reinterpret_cast<const bf16x8*>(kb+d0*2048);
    const bf16x8 b1=*reinterpret_cast<const bf16x8*>(kb+d0*2048+512);
    if(d0==0){p0=__builtin_amdgcn_mfma_f32_32x32x16_bf16(b0,qr[0],negm,0,0,0);p1=__builtin_amdgcn_mfma_f32_32x32x16_bf16(b1,qr[0],negm,0,0,0);}
    else{p0=__builtin_amdgcn_mfma_f32_32x32x16_bf16(b0,qr[d0],p0,0,0,0);p1=__builtin_amdgcn_mfma_f32_32x32x16_bf16(b1,qr[d0],p1,0,0,0);}}
}
typedef __attribute__((address_space(3))) const char* lds_cptr;
typedef short v4i16_t __attribute__((ext_vector_type(4)));
__device__ __forceinline__ void kload8(bf16x8*kf,lds_cptr kp){
  kf[0]=*(const __attribute__((address_space(3))) bf16x8*)(kp);      kf[1]=*(const __attribute__((address_space(3))) bf16x8*)(kp+512);
  kf[2]=*(const __attribute__((address_space(3))) bf16x8*)(kp+2048); kf[3]=*(const __attribute__((address_space(3))) bf16x8*)(kp+2560);
  kf[4]=*(const __attribute__((address_space(3))) bf16x8*)(kp+4096); kf[5]=*(const __attribute__((address_space(3))) bf16x8*)(kp+4608);
  kf[6]=*(const __attribute__((address_space(3))) bf16x8*)(kp+6144); kf[7]=*(const __attribute__((address_space(3))) bf16x8*)(kp+6656);
}
__device__ __forceinline__ void kload2(bf16x8*kf,lds_cptr kp,int j){ kf[2*j]=*(const __attribute__((address_space(3))) bf16x8*)(kp+j*2048); kf[2*j+1]=*(const __attribute__((address_space(3))) bf16x8*)(kp+j*2048+512); }
__device__ __forceinline__ s16x4 vtr(lds_cptr p){ return __builtin_bit_cast(s16x4,__builtin_amdgcn_ds_read_tr16_b64_v4i16((__attribute__((address_space(3))) v4i16_t*)p)); }
__device__ __forceinline__ float rowmax(const f32x16&p0,const f32x16&p1){
  float a=max3f(p0[0],p0[1],p1[0]),b=max3f(p0[2],p0[3],p1[1]);a=max3f(a,p1[2],p1[3]);
  #pragma unroll
  for(int r=4;r<16;r+=4){a=max3f(a,p0[r],p0[r+1]);b=max3f(b,p0[r+2],p0[r+3]);a=max3f(a,p1[r],p1[r+1]);b=max3f(b,p1[r+2],p1[r+3]);}
  const float m=max2f(a,b);
  auto rr=__builtin_amdgcn_permlane32_swap(__float_as_uint(m),__float_as_uint(m),false,false);
  return max2f(__uint_as_float(rr[0]),__uint_as_float(rr[1]));
}
__device__ __forceinline__ void pv(f32x16*o,int vb,bf16x8 pa0,bf16x8 pa1,bf16x8 pa2,bf16x8 pa3){
  #pragma unroll
  for(int d0=0;d0<2;++d0){s16x4 lo[4],hi[4];
    #pragma unroll
    for(int ks=0;ks<4;++ks){
      asm volatile("ds_read_b64_tr_b16 %0,%1 offset:%c2":"=&v"(lo[ks]):"v"(vb),"i"(d0*4096+ks*1024):"memory");
      asm volatile("ds_read_b64_tr_b16 %0,%1 offset:%c2":"=&v"(hi[ks]):"v"(vb),"i"(d0*4096+ks*1024+512):"memory");}
    asm volatile("s_waitcnt lgkmcnt(0)":::"memory");SBAR();
    #define PK(k) (bf16x8){lo[k][0],lo[k][1],lo[k][2],lo[k][3],hi[k][0],hi[k][1],hi[k][2],hi[k][3]}
    o[d0]=__builtin_amdgcn_mfma_f32_32x32x16_bf16(pa0,PK(0),o[d0],0,0,0);
    o[d0]=__builtin_amdgcn_mfma_f32_32x32x16_bf16(pa1,PK(1),o[d0],0,0,0);
    o[d0]=__builtin_amdgcn_mfma_f32_32x32x16_bf16(pa2,PK(2),o[d0],0,0,0);
    o[d0]=__builtin_amdgcn_mfma_f32_32x32x16_bf16(pa3,PK(3),o[d0],0,0,0);
    #undef PK
  }
}

#ifndef ATTN_STORE16
#define ATTN_STORE16(p,v) (*(u32x4*)(p)=(v))
#endif
template<int THRL> __device__ __forceinline__ void attn_unit(int b,int h,int hv,int qb,const bf16*Q,const bf16*__restrict__ K,const bf16*__restrict__ V,bf16*O,char*shm){
  int tid_=threadIdx.x; asm volatile("":"+v"(tid_)); const int tid=tid_,lane=tid&63,r32=lane&31,hi=lane>>5; const int wid=__builtin_amdgcn_readfirstlane(tid>>6);
  const long rowbase=(long)b*SEQ; const int q0=qb*QB;
  const bf16*Qw=Q+(rowbase+q0+wid*QBLK)*DM+h*D;
  const bf16*Kh=K+rowbase*DM+h*D,*Vh=V+rowbase*DM+hv*D;
  const unsigned lds0=(unsigned)(uintptr_t)shm;
  float*wsf=(float*)(shm+LDS_WS)+wid*64;
  const bf16*ksrc=Kh+(long)lane*DM+wid*8;
  const bf16*vsrc=Vh+(long)(16*(wid&3)+(lane>>2))*DM+(wid>>2)*32+(lane&3)*8;
  const unsigned kdst=lds0+LDS_K+wid*1024, vdst=lds0+LDS_V+wid*1024;
  #define DMA_K(t,slot) glds16(ksrc+(long)(t)*KVBLK*DM,(unsigned)__builtin_amdgcn_readfirstlane(kdst+(slot)))
  #define DMA_V(t,slot) glds16(vsrc+(long)(t)*KVBLK*DM,(unsigned)__builtin_amdgcn_readfirstlane(vdst+(slot)))
  const int vb0=(int)(lds0+LDS_V)+((lane>>4)&1)*32+(lane&3)*8+(4*hi+((lane&15)>>2))*64;
  const char*Kbase=shm+LDS_K; bf16x8 kf[8];
  const lds_cptr shm3=(lds_cptr)shm; const lds_cptr kp0=shm3+LDS_K+hi*1024+r32*16; const lds_cptr vp0=shm3+LDS_V+((lane>>4)&1)*32+(lane&3)*8+(4*hi+((lane&15)>>2))*64;
  const int NT=(q0+QB)/KVBLK;
  DMA_K(0,0);DMA_V(0,0);DMA_K(1,SLOTB);
  bf16x8 qr[4];
  #pragma unroll
  for(int d0=0;d0<4;++d0)qr[d0]=*reinterpret_cast<const bf16x8*>(&Qw[(long)r32*DM+d0*16+hi*8]);
  float mhat=0.f,l_reg=0.f;f32x16 o[2];o[0]=f32x16{};o[1]=f32x16{};f32x16 negm=f32x16{};asm volatile("":"+v"(negm));
  const int qrel=wid*QBLK+r32;
  #define CMASK(P0,P1,t) do{int jb_=(t)-(NT-4); if(jb_>=0)cmask(P0,P1,jb_,qrel,hi);}while(0)
  bool resc=false;
  #define START(P0,P1) do{ const float rm=rowmax(P0,P1); resc=false; \
    { const float dl=rm; mhat=fadd_s(mhat,dl); \
      _Pragma("unroll") for(int r=0;r<16;++r){P0[r]=fsub_s(P0[r],dl);P1[r]=fsub_s(P1[r],dl);} \
      _Pragma("unroll") for(int r=0;r<16;++r)negm[r]=-mhat; asm volatile("":"+v"(negm)); } \
    _Pragma("unroll") for(int r=0;r<16;++r)P0[r]=__builtin_amdgcn_exp2f(P0[r]); }while(0)
  #define RESC() do{ if(resc){ asm volatile("s_waitcnt lgkmcnt(0)":::"memory"); \
      _Pragma("unroll") for(int d_=0;d_<2;++d_) _Pragma("unroll") for(int r=0;r<16;++r)o[d_][r]*=wsf[crow(r,hi)]; } }while(0)
  f32x16 pA0,pA1,pB0,pB1;
  int sl_prev=0,sl_cur=0,sl_next=SLOTB;
  #define ROT() do{sl_prev=sl_cur;sl_cur=sl_next;sl_next=(sl_next==(NSLOT-1)*SLOTB)?0:sl_next+SLOTB;}while(0)
  DMA_K(2,2*SLOTB);
  WAIT_BAR(3);
  qkt(pA0,pA1,Kbase,qr,negm,r32,hi);asm volatile("s_nop 15\n\ts_nop 7":"+v"(pA0),"+v"(pA1));CMASK(pA0,pA1,0);
  START(pA0,pA1);
  _Pragma("unroll") for(int r=0;r<16;++r)pA1[r]=__builtin_amdgcn_exp2f(pA1[r]);
  WAIT_BAR(0);
  DMA_K(3,0);DMA_V(1,SLOTB);
  ROT();
  kload8(kf,kp0+sl_cur);
  WAIT_BAR(2);
  s16x4 vlo[8],vhi[8]; u32x4 pw0,pw1,pw2,pw3;
  #define PKW(P,B) cvtpk_s(P[B],P[B+1])
  #define PAF(k) __builtin_bit_cast(bf16x8,pw##k)
  #define VFR(i) (bf16x8){vlo[i][0],vlo[i][1],vlo[i][2],vlo[i][3],vhi[i][0],vhi[i][1],vhi[i][2],vhi[i][3]}
  #define PIN(x) asm volatile("":"+v"(x))
  #define MX3(a,b,c) __builtin_fmaxf(__builtin_fmaxf((a),(b)),(c))
  #define GAPA(MF,A0,A1,A2,A3,W0,W1,PW) do{ MF; sacc+=A0; sacc+=A1; sacc+=A2; sacc+=A3; PIN(sacc); W0; W1; PIN(PW); SBAR(); }while(0)
  #define EX(v) __builtin_amdgcn_exp2f(v)
  #define GAPB(MF,X,B) do{ MF; X[B]=EX(X[B]); X[B+1]=EX(X[B+1]); X[B+2]=EX(X[B+2]); X[B+3]=EX(X[B+3]); PIN(X); SBAR(); }while(0)
  #define VRD(i) do{ vlo[i]=vtr(vp_+(((i)>>2)*4096+((i)&3)*1024)); vhi[i]=vtr(vp_+(((i)>>2)*4096+((i)&3)*1024+512)); }while(0)
  #define KRD(G,j) do{ if(G){ kload2(kf,kp0+sl_next,j); SBAR(); } }while(0)
  #define STEP(C0,C1,P0,P1,t,GK,GV,GL) do{ SBAR(); \
    const lds_cptr vp_=vp0+sl_prev; \
    VRD(0); SBAR(); float sacc=(P0[0]+P0[1]); \
    GAPA(C0=__builtin_amdgcn_mfma_f32_32x32x16_bf16(kf[0],qr[0],negm,0,0,0), P0[2],P0[3],P0[4],P0[5],     pw0[0]=PKW(P0,0), pw0[1]=PKW(P0,2), pw0); \
    VRD(4); SBAR(); GAPA(C1=__builtin_amdgcn_mfma_f32_32x32x16_bf16(kf[1],qr[0],negm,0,0,0), P0[6],P0[7],P0[8],P0[9],     pw0[2]=PKW(P0,4), pw0[3]=PKW(P0,6), pw0); \
    VRD(1); SBAR(); GAPA(C0=__builtin_amdgcn_mfma_f32_32x32x16_bf16(kf[2],qr[1],C0,0,0,0),   P0[10],P0[11],P0[12],P0[13], pw1[0]=PKW(P0,8), pw1[1]=PKW(P0,10), pw1); \
    VRD(5); SBAR(); GAPA(C1=__builtin_amdgcn_mfma_f32_32x32x16_bf16(kf[3],qr[1],C1,0,0,0),   P0[14],P0[15],P1[0],P1[1],   pw1[2]=PKW(P0,12),pw1[3]=PKW(P0,14), pw1); \
    VRD(2); SBAR(); GAPA(C0=__builtin_amdgcn_mfma_f32_32x32x16_bf16(kf[4],qr[2],C0,0,0,0),   P1[2],P1[3],P1[4],P1[5],     pw2[0]=PKW(P1,0), pw2[1]=PKW(P1,2), pw2); \
    VRD(6); SBAR(); GAPA(C1=__builtin_amdgcn_mfma_f32_32x32x16_bf16(kf[5],qr[2],C1,0,0,0),   P1[6],P1[7],P1[8],P1[9],     pw2[2]=PKW(P1,4), pw2[3]=PKW(P1,6), pw2); \
    VRD(3); SBAR(); GAPA(C0=__builtin_amdgcn_mfma_f32_32x32x16_bf16(kf[6],qr[3],C0,0,0,0),   P1[10],P1[11],P1[12],P1[13], pw3[0]=PKW(P1,8), pw3[1]=PKW(P1,10), pw3); \
    VRD(7); SBAR(); GAPA(C1=__builtin_amdgcn_mfma_f32_32x32x16_bf16(kf[7],qr[3],C1,0,0,0),   P1[14],P1[15],0.f,0.f,       pw3[2]=PKW(P1,12),pw3[3]=PKW(P1,14), pw3); \
    l_reg+=sacc; \
    if(GK){DMA_K((t)+3,sl_cur);} if(GV){DMA_V((t)+1,sl_next);} \
    CMASK(C0,C1,t); \
    { float a=MX3(C0[0],C0[1],C1[0]),b=MX3(C0[2],C0[3],C1[1]); a=MX3(a,C1[2],C1[3]); \
      _Pragma("unroll") for(int r=4;r<16;r+=4){a=MX3(a,C0[r],C0[r+1]);b=MX3(b,C0[r+2],C0[r+3]);a=MX3(a,C1[r],C1[r+1]);b=MX3(b,C1[r+2],C1[r+3]);} \
      float rm=__builtin_fmaxf(a,b); { auto rr=__builtin_amdgcn_permlane32_swap(__float_as_uint(rm),__float_as_uint(rm),false,false); rm=__builtin_fmaxf(__uint_as_float(rr[0]),__uint_as_float(rr[1])); } \
      resc=false; \
      if(__builtin_expect(__any(rm>(float)THRL),0)){ const float dl=__builtin_fmaxf(rm,0.f); mhat+=dl; \
        _Pragma("unroll") for(int r=0;r<16;++r){C0[r]-=dl;C1[r]-=dl;} \
        _Pragma("unroll") for(int r=0;r<16;++r)negm[r]=-mhat; asm volatile("":"+v"(negm)); \
        const float f=__builtin_amdgcn_exp2f(-dl); l_reg*=f; if(hi==0)wsf[r32]=f; resc=true; } } \
    SBAR(); \
    GAPB(o[0]=__builtin_amdgcn_mfma_f32_32x32x16_bf16(PAF(0),VFR(0),o[0],0,0,0), C0,0); \
    GAPB(o[1]=__builtin_amdgcn_mfma_f32_32x32x16_bf16(PAF(0),VFR(4),o[1],0,0,0), C0,4); \
    KRD(GL,0); GAPB(o[0]=__builtin_amdgcn_mfma_f32_32x32x16_bf16(PAF(1),VFR(1),o[0],0,0,0), C0,8); \
    KRD(GL,1); GAPB(o[1]=__builtin_amdgcn_mfma_f32_32x32x16_bf16(PAF(1),VFR(5),o[1],0,0,0), C0,12); \
    KRD(GL,2); GAPB(o[0]=__builtin_amdgcn_mfma_f32_32x32x16_bf16(PAF(2),VFR(2),o[0],0,0,0), C1,0); \
    KRD(GL,3); GAPB(o[1]=__builtin_amdgcn_mfma_f32_32x32x16_bf16(PAF(2),VFR(6),o[1],0,0,0), C1,4); \
    GAPB(o[0]=__builtin_amdgcn_mfma_f32_32x32x16_bf16(PAF(3),VFR(3),o[0],0,0,0), C1,8); \
    GAPB(o[1]=__builtin_amdgcn_mfma_f32_32x32x16_bf16(PAF(3),VFR(7),o[1],0,0,0), C1,12); \
    }while(0)
  int t=1;
  #undef CMASK
  #define CMASK(P0,P1,t) do{}while(0)
  for(;t+5<NT;t+=2){
    STEP(pB0,pB1,pA0,pA1,t,true,true,true);     WAIT_BAR(2); RESC(); ROT();
    STEP(pA0,pA1,pB0,pB1,t+1,true,true,true);   WAIT_BAR(2); RESC(); ROT();
  }
  #undef CMASK
  #define CMASK(P0,P1,t) do{int jb_=(t)-(NT-4); if(jb_>=0)cmask(P0,P1,jb_,qrel,hi);}while(0)
  #define ENDW(tt) do{ if((tt)+3<NT){WAIT_BAR(2);} else if((tt)+2<NT){WAIT_BAR(1);} else {WAIT_BAR(0);} }while(0)
  for(;t+1<NT;t+=2){
    STEP(pB0,pB1,pA0,pA1,t,(t+3<NT),(t+1<NT),(t+1<NT));       ENDW(t);   RESC(); ROT();
    STEP(pA0,pA1,pB0,pB1,t+1,(t+4<NT),(t+2<NT),(t+2<NT));     ENDW(t+1); RESC(); ROT();
  }
  STEP(pB0,pB1,pA0,pA1,NT-1,false,false,false); RESC();
  { float sacc=pB0[0]+pB0[1]; _Pragma("unroll") for(int r=2;r<16;++r)sacc+=pB0[r]; _Pragma("unroll") for(int r=0;r<16;++r)sacc+=pB1[r]; l_reg+=sacc;
    pw0=(u32x4){PKW(pB0,0),PKW(pB0,2),PKW(pB0,4),PKW(pB0,6)};pw1=(u32x4){PKW(pB0,8),PKW(pB0,10),PKW(pB0,12),PKW(pB0,14)};pw2=(u32x4){PKW(pB1,0),PKW(pB1,2),PKW(pB1,4),PKW(pB1,6)};pw3=(u32x4){PKW(pB1,8),PKW(pB1,10),PKW(pB1,12),PKW(pB1,14)};
    SBAR(); pv(o,vb0+sl_cur,PAF(0),PAF(1),PAF(2),PAF(3)); }
  #undef PKW
  #undef PAF
  #undef VFR
  #undef PIN
  #undef MX3
  #undef GAPA
  #undef GAPB
  #undef EX
  #undef VRD
  #undef KRD
  #undef STEP
  #undef ENDW
  {auto rr=__builtin_amdgcn_permlane32_swap(__float_as_uint(l_reg),__float_as_uint(l_reg),false,false);l_reg=__uint_as_float(rr[0])+__uint_as_float(rr[1]);}
  if(hi==0)wsf[32+r32]=l_reg;asm volatile("s_waitcnt lgkmcnt(0)":::"memory");
  float rli[16];
  #pragma unroll
  for(int r=0;r<16;++r)rli[r]=__builtin_amdgcn_rcpf(wsf[32+crow(r,hi)]);
  bf16*Ow=O+(rowbase+q0+wid*QBLK)*DM+hv*D;
  { bf16*stg=(bf16*)(shm+LDS_OST)+wid*2048;
    #pragma unroll
    for(int r=0;r<16;++r){const int orow=crow(r,hi);
      #pragma unroll
      for(int d0=0;d0<2;++d0)stg[orow*64+d0*32+r32]=__float2bfloat16(o[d0][r]*rli[r]);}
    asm volatile("s_waitcnt lgkmcnt(0)":::"memory");
    #pragma unroll
    for(int i=0;i<4;++i){const int row=i*8+(lane>>3),ch=lane&7; const u32x4 v=*(const u32x4*)(stg+row*64+ch*8); ATTN_STORE16(Ow+(long)row*DM+ch*8,v);} }
  asm volatile("s_waitcnt lgkmcnt(0)\n\ts_barrier":::"memory");
  #undef DMA_K
  #undef DMA_V
  #undef CMASK
  #undef START
  #undef RESC
  #undef ROT
}
constexpr int ATTN_LDS_BYTES=LDS_BYTES;
struct AttnTensors { const bf16* Q; const bf16* K; const bf16* V; bf16* O1; bf16* O2; };
struct AttnUnit { int combo; int qb; };
struct StaticOrder {
  int vcu,G,blk;
  __device__ __forceinline__ explicit StaticOrder(int grid,int block):vcu((grid%8==0)?(block%8)*(grid/8)+block/8:block),G(grid),blk(block){}
  __device__ __forceinline__ bool next(int i,AttnUnit&u)const{
    if(G==256){ if(i>=32)return false; const int s=vcu&7,j=i&3; u.combo=(i>>2)*32+(vcu>>3); u.qb=(j==0)?s:(j==1)?15-s:(j==2)?16+s:31-s; return true; }
    const long L=(long)i*G+blk; if(L>=8192)return false; u.combo=(int)(L>>5); u.qb=31-(int)(L&31); return true; }
};
template<class Sched,int THRL=8> __device__ __forceinline__ void attn_phase(char*lds,const AttnTensors&T,const Sched&S){
  AttnUnit u;
  for(int i=0;S.next(i,u);++i){ const int b=u.combo>>5,hq=(u.combo>>1)&15,vh=u.combo&1; const int hv=(hq>>1)*2+vh;
    attn_unit<THRL>(b,hq,hv,u.qb,T.Q,T.K,T.V,(hq&1)?T.O2:T.O1,lds); }
}
#undef SBAR
#undef WAIT_BAR
}

#include <hip/hip_cooperative_groups.h>
namespace cg = cooperative_groups;

constexpr int NWAVES = 8;
#ifndef STOP_AFTER
#define STOP_AFTER 99
#endif
constexpr int DM = 1024, FF = 4096, NP = 65536, NS = 256, M = NP + NS;
constexpr float EPS = 1e-6f;
constexpr float LAM_INIT = 0.35550906759f;
constexpr size_t O_Y = 0, O_KP = (size_t)M * DM, O_VP = O_KP + (size_t)NP * DM, O_STP = O_VP + (size_t)NP * DM, O_KS = O_STP + (size_t)8 * 8 * 128 * 128,
                 O_VS = O_KS + (size_t)NS * DM, O_STS = O_VS + (size_t)NS * DM, O_END = O_STS + (size_t)16 * 8 * 128 * 128;
constexpr size_t MiB = 1u << 20;
constexpr size_t WS_OML = 1 * MiB;
constexpr size_t WS_WIN = 2 * MiB, WS_WHO = 10 * MiB, WS_WUP0 = 12 * MiB, WS_WDN0 = 20 * MiB, WS_WQKV = 28 * MiB, WS_WDO = 34 * MiB, WS_WUP1 = 36 * MiB, WS_WDN1 = 44 * MiB;
constexpr size_t WS_XN = 64 * MiB;
constexpr size_t WS_MB = 196 * MiB;
constexpr size_t WS_R0 = 328 * MiB;
constexpr size_t WS_Q = WS_R0, WS_K = WS_R0 + 130 * MiB, WS_V = WS_R0 + 260 * MiB, WS_O1 = WS_R0 + 390 * MiB;
constexpr size_t WS_O2 = WS_R0 + 520 * MiB;
constexpr size_t WS_PACC = WS_O2 + 130 * MiB;
constexpr size_t WS_END = WS_PACC + 4 * MiB;
constexpr int SPLK = 4;
constexpr size_t WS_RS = 1 * MiB + 65536;
static_assert(WS_O2 + (size_t)M * DM * 2 <= WS_END && WS_END <= 1024 * MiB && WS_O1 + (size_t)M * DM * 2 <= WS_O2 && WS_R0 + (size_t)M * FF * 2 <= WS_END && WS_XN + (size_t)M * DM * 2 <= WS_MB && WS_MB + (size_t)M * DM * 2 <= WS_R0, "d_ws map");

constexpr int RING_OFF = 0, RING_BYTES = 131072;
constexpr int LDS_BYTES = 155648;

#define GAS __attribute__((address_space(1)))
#define LAS __attribute__((address_space(3)))
typedef unsigned short bf16;
typedef unsigned v4u __attribute__((ext_vector_type(4)));
typedef unsigned v2u __attribute__((ext_vector_type(2)));
typedef float f32x4 __attribute__((ext_vector_type(4)));
typedef short bf16x8 __attribute__((ext_vector_type(8)));
#define LDS_WAIT() asm volatile("s_waitcnt lgkmcnt(0)" ::: "memory")
__device__ __forceinline__ unsigned pk2(float lo, float hi) { return pg8::cvt_pk_bf16(lo, hi); }
__device__ __forceinline__ float bf2f(unsigned short u) { return __uint_as_float((unsigned)u << 16); }
__device__ __forceinline__ float bflo(unsigned u) { return __uint_as_float(u << 16); }
__device__ __forceinline__ float bfhi(unsigned u) { return __uint_as_float(u & 0xffff0000u); }
template <int CTRL> __device__ __forceinline__ float dpp_f(float v) { return __builtin_bit_cast(float, __builtin_amdgcn_update_dpp(0, __builtin_bit_cast(int, v), CTRL, 0xf, 0xf, true)); }
__device__ __forceinline__ float wave_sum(float v) {
#pragma unroll
    for (int o = 1; o < 64; o <<= 1) v += __shfl_xor(v, o);
    return v;
}
__device__ __forceinline__ float wave_max(float v) {
#pragma unroll
    for (int o = 1; o < 64; o <<= 1) v = fmaxf(v, __shfl_xor(v, o));
    return v;
}

struct Frame {
    LAS unsigned char* lds;
    int tid, lane, wave, vcu, G;
};

__device__ __forceinline__ void p0_transpose_item(const float* W, const float* gain, int K, int N, bf16* WT, int row_off, LAS float* scr, int item, int lane) {
    const int nblk = N / 32, kb = item / nblk, nb = item % nblk, k0 = 64 * kb, n0 = 32 * nb;
    if (gain) {
        float wv[32], gv[32];
#pragma unroll
        for (int i = 0; i < 32; ++i) { const int kk = 2 * i + (lane >> 5); wv[i] = W[(size_t)(k0 + kk) * N + n0 + (lane & 31)]; gv[i] = gain[k0 + kk]; }
#pragma unroll
        for (int i = 0; i < 32; ++i) { const int kk = 2 * i + (lane >> 5); scr[kk * 33 + (lane & 31)] = gv[i] * wv[i]; }
    } else {
        float wv[32];
#pragma unroll
        for (int i = 0; i < 32; ++i) { const int kk = 2 * i + (lane >> 5); wv[i] = W[(size_t)(k0 + kk) * N + n0 + (lane & 31)]; }
#pragma unroll
        for (int i = 0; i < 32; ++i) { const int kk = 2 * i + (lane >> 5); scr[kk * 33 + (lane & 31)] = wv[i]; }
    }
    LDS_WAIT(); asm volatile("" ::: "memory");
    const int c = lane & 7;
#pragma unroll
    for (int j = 0; j < 4; ++j) { const int n = (lane >> 3) + 8 * j; const LAS float* s = scr + (8 * c) * 33 + n;
        v4u o; o.x = pk2(s[0 * 33], s[1 * 33]); o.y = pk2(s[2 * 33], s[3 * 33]); o.z = pk2(s[4 * 33], s[5 * 33]); o.w = pk2(s[6 * 33], s[7 * 33]);
        *(v4u*)(WT + (size_t)(row_off + n0 + n) * K + k0 + 8 * c) = o; }
    LDS_WAIT(); asm volatile("" ::: "memory");
}

struct Args {
    const float* in[18]; float* out; unsigned char* ws;
};

__device__ __forceinline__ void rms_row_to_bf16(const float* xrow, bf16* orow, float* rs, int lane) {
    const f32x4* xr = (const f32x4*)xrow;
    f32x4 v[4]; v[0] = xr[2 * lane]; v[1] = xr[2 * lane + 1]; v[2] = xr[128 + 2 * lane]; v[3] = xr[128 + 2 * lane + 1];
    float s = 0.f;
#pragma unroll
    for (int j = 0; j < 4; ++j) s += (v[j].x * v[j].x + v[j].y * v[j].y) + (v[j].z * v[j].z + v[j].w * v[j].w);
    const float ms = wave_sum(s) * (1.f / DM) + EPS; const float r = rsqrtf(ms);
    if (lane == 0) *rs = sqrtf(ms);
    v4u o0, o1;
    o0.x = pk2(v[0].x * r, v[0].y * r); o0.y = pk2(v[0].z * r, v[0].w * r); o0.z = pk2(v[1].x * r, v[1].y * r); o0.w = pk2(v[1].z * r, v[1].w * r);
    o1.x = pk2(v[2].x * r, v[2].y * r); o1.y = pk2(v[2].z * r, v[2].w * r); o1.z = pk2(v[3].x * r, v[3].y * r); o1.w = pk2(v[3].z * r, v[3].w * r);
    *(v4u*)(orow + 8 * lane) = o0; *(v4u*)(orow + 512 + 8 * lane) = o1;
}

template <bool LAST>
__device__ __forceinline__ void norm_phase(const Frame& F, const bf16* MB, const float* pacc, const float* gpost, float* RS, float* out, bf16* XN) {
    const int gw = F.vcu * NWAVES + F.wave, NGW = F.G * NWAVES, lane = F.lane;
    f32x4 g[4]; { const f32x4* gp = (const f32x4*)gpost; g[0] = gp[2 * lane]; g[1] = gp[2 * lane + 1]; g[2] = gp[128 + 2 * lane]; g[3] = gp[128 + 2 * lane + 1]; }
    for (int row = gw; row < M; row += NGW) {
        const v4u m0 = *(const v4u*)(MB + (size_t)row * DM + 8 * lane), m1 = *(const v4u*)(MB + (size_t)row * DM + 512 + 8 * lane);
        const v4u x0 = *(const v4u*)(XN + (size_t)row * DM + 8 * lane), x1 = *(const v4u*)(XN + (size_t)row * DM + 512 + 8 * lane);
        const float hs = RS[row];
        f32x4 v[4], mm[4];
        v[0] = (f32x4){bflo(x0.x), bfhi(x0.x), bflo(x0.y), bfhi(x0.y)}; v[1] = (f32x4){bflo(x0.z), bfhi(x0.z), bflo(x0.w), bfhi(x0.w)};
        v[2] = (f32x4){bflo(x1.x), bfhi(x1.x), bflo(x1.y), bfhi(x1.y)}; v[3] = (f32x4){bflo(x1.z), bfhi(x1.z), bflo(x1.w), bfhi(x1.w)};
        mm[0] = (f32x4){bflo(m0.x), bfhi(m0.x), bflo(m0.y), bfhi(m0.y)}; mm[1] = (f32x4){bflo(m0.z), bfhi(m0.z), bflo(m0.w), bfhi(m0.w)};
        mm[2] = (f32x4){bflo(m1.x), bfhi(m1.x), bflo(m1.y), bfhi(m1.y)}; mm[3] = (f32x4){bflo(m1.z), bfhi(m1.z), bflo(m1.w), bfhi(m1.w)};
        if (row >= NP) {
            const f32x4* pp = (const f32x4*)(pacc + (size_t)(row - NP) * DM);
            mm[0] = pp[2 * lane]; mm[1] = pp[2 * lane + 1]; mm[2] = pp[128 + 2 * lane]; mm[3] = pp[128 + 2 * lane + 1];
#pragma unroll
            for (int p = 1; p < SPLK; ++p) { const f32x4* pq_ = pp + (size_t)p * (NS * DM / 4); mm[0] += pq_[2 * lane]; mm[1] += pq_[2 * lane + 1]; mm[2] += pq_[128 + 2 * lane]; mm[3] += pq_[128 + 2 * lane + 1]; }
        }
        float s = 0.f;
#pragma unroll
        for (int j = 0; j < 4; ++j) s += (mm[j].x * mm[j].x + mm[j].y * mm[j].y) + (mm[j].z * mm[j].z + mm[j].w * mm[j].w);
        const float r = rsqrtf(wave_sum(s) * (1.f / DM) + EPS);
        float s2 = 0.f;
#pragma unroll
        for (int j = 0; j < 4; ++j) { v[j] = v[j] * hs + mm[j] * r * g[j]; s2 += (v[j].x * v[j].x + v[j].y * v[j].y) + (v[j].z * v[j].z + v[j].w * v[j].w); }
        if (LAST) {
            f32x4* dr = (f32x4*)(out + (size_t)row * DM);
            dr[2 * lane] = v[0]; dr[2 * lane + 1] = v[1]; dr[128 + 2 * lane] = v[2]; dr[128 + 2 * lane + 1] = v[3];
        } else {
            const float ms = wave_sum(s2) * (1.f / DM) + EPS; const float r2 = rsqrtf(ms);
            if (lane == 0) RS[row] = sqrtf(ms);
            v4u o0, o1;
            o0.x = pk2(v[0].x * r2, v[0].y * r2); o0.y = pk2(v[0].z * r2, v[0].w * r2); o0.z = pk2(v[1].x * r2, v[1].y * r2); o0.w = pk2(v[1].z * r2, v[1].w * r2);
            o1.x = pk2(v[2].x * r2, v[2].y * r2); o1.y = pk2(v[2].z * r2, v[2].w * r2); o1.z = pk2(v[3].x * r2, v[3].y * r2); o1.w = pk2(v[3].z * r2, v[3].w * r2);
            *(v4u*)(XN + (size_t)row * DM + 8 * lane) = o0; *(v4u*)(XN + (size_t)row * DM + 512 + 8 * lane) = o1;
        }
    }
}

__device__ __forceinline__ float compute_lam(const float* lp, int lane) {
    const float a = wave_sum(lp[lane] * lp[64 + lane]), b = wave_sum(lp[128 + lane] * lp[192 + lane]);
    return __expf(a) - __expf(b) + LAM_INIT;
}

__device__ __forceinline__ void combine_phase(const Frame& F, const bf16* O1, const bf16* O2, const float* lp, const float* subg, bf16* OC) {
    const int gw = F.vcu * NWAVES + F.wave, NGW = F.G * NWAVES, lane = F.lane;
    const float lam = compute_lam(lp, lane);
    float sg[16];
#pragma unroll
    for (int e = 0; e < 16; ++e) sg[e] = subg[16 * (lane & 7) + e] * (1.0f - LAM_INIT);
    for (int row = gw; row < NP; row += NGW) {
        const size_t off = (size_t)row * DM + 16 * lane;
        const v4u a0 = *(const v4u*)(O1 + off), a1 = *(const v4u*)(O1 + off + 8), b0 = *(const v4u*)(O2 + off), b1 = *(const v4u*)(O2 + off + 8);
        float o[16];
        const unsigned aw[8] = {a0.x, a0.y, a0.z, a0.w, a1.x, a1.y, a1.z, a1.w}, bw[8] = {b0.x, b0.y, b0.z, b0.w, b1.x, b1.y, b1.z, b1.w};
        float s = 0.f;
#pragma unroll
        for (int e = 0; e < 8; ++e) { o[2 * e] = bflo(aw[e]) - lam * bflo(bw[e]); o[2 * e + 1] = bfhi(aw[e]) - lam * bfhi(bw[e]); s += o[2 * e] * o[2 * e] + o[2 * e + 1] * o[2 * e + 1]; }
        s += __shfl_xor(s, 1); s += __shfl_xor(s, 2); s += __shfl_xor(s, 4);
        const float r = rsqrtf(s * (1.f / 128.f) + EPS);
        v4u w0, w1;
        w0.x = pk2(o[0] * r * sg[0], o[1] * r * sg[1]); w0.y = pk2(o[2] * r * sg[2], o[3] * r * sg[3]); w0.z = pk2(o[4] * r * sg[4], o[5] * r * sg[5]); w0.w = pk2(o[6] * r * sg[6], o[7] * r * sg[7]);
        w1.x = pk2(o[8] * r * sg[8], o[9] * r * sg[9]); w1.y = pk2(o[10] * r * sg[10], o[11] * r * sg[11]); w1.z = pk2(o[12] * r * sg[12], o[13] * r * sg[13]); w1.w = pk2(o[14] * r * sg[14], o[15] * r * sg[15]);
        *(v4u*)(OC + off) = w0; *(v4u*)(OC + off + 8) = w1;
    }
}

namespace hg {
#define HGT 0
constexpr int QT_P = 136, KH_P = 72, ST_P = 136;
constexpr int L_QT = 0, L_KT = 17408, L_KHT = 34816, L_VT = 53248, L_AM = 71680, L_ST = 80896, L_BSUM = 115712, L_DL = 117760, L_SSQ = 118272, L_OST = 118784, OST_P = 72, L_RV = L_OST + 8 * 16 * OST_P * 2, L_END = L_RV + 64 * QT_P * 2;
static_assert(L_END <= LDS_BYTES, "hgrn LDS");
#define HG_MFMA(a, b, c) __builtin_amdgcn_mfma_f32_16x16x32_bf16((a), (b), (c), 0, 0, 0)
template <int ntok>
__device__ __forceinline__ void hgrn_item(LAS unsigned char* lds, const bf16* HG, bf16* OUT, const float* S0, float* Sout, long row0, int nchunk, int h, const float* onorm_g) {
    int tid_ = threadIdx.x; asm volatile("" : "+v"(tid_));
    const int tid = tid_, lane = tid & 63, wid = __builtin_amdgcn_readfirstlane(tid >> 6);
    const int kc = tid & 127, qt = wid >> 1, fr = lane & 15, fq = lane >> 4;
    LAS bf16* Qt = (LAS bf16*)(lds + L_QT); LAS bf16* Kt = (LAS bf16*)(lds + L_KT); LAS bf16* KhT = (LAS bf16*)(lds + L_KHT); LAS bf16* VT = (LAS bf16*)(lds + L_VT);
    LAS bf16* Am = (LAS bf16*)(lds + L_AM); LAS bf16* ST = (LAS bf16*)(lds + L_ST);
    LAS bf16* ost = (LAS bf16*)(lds + L_OST) + wid * (16 * OST_P);
    LAS float* bsum = (LAS float*)(lds + L_BSUM); LAS float* dlast = (LAS float*)(lds + L_DL); LAS float* ssq = (LAS float*)(lds + L_SSQ);
    const int ti = wid >> 1, vh = wid & 1;
    f32x4 sacc[8];
#pragma unroll
    for (int vt = 0; vt < 8; ++vt) {
#pragma unroll
        for (int i = 0; i < 4; ++i) sacc[vt][i] = S0 ? S0[(size_t)(16 * wid + 4 * fq + i) * 128 + 16 * vt + fr] : 0.f;
    }
    __syncthreads();
#pragma unroll
    for (int vt = 0; vt < 8; ++vt) { v2u w; w.x = pk2(sacc[vt][0], sacc[vt][1]); w.y = pk2(sacc[vt][2], sacc[vt][3]); *(LAS v2u*)(ST + (16 * vt + fr) * ST_P + 16 * wid + 4 * fq) = w; }
    float og[4];
#pragma unroll
    for (int j = 0; j < 4; ++j) og[j] = onorm_g[h * 128 + 16 * (4 * vh + j) + fr];
    LAS bf16* RV = (LAS bf16*)(lds + L_RV);
    v4u pq[2], pk[2], pv[2], pg[2];
#define HG_LOAD(c) do { _Pragma("unroll") for (int e = 0; e < 2; ++e) { const int id = tid + 512 * e, r_ = id >> 4, pc = id & 15; const int rc = (ntok >= 64 || r_ < ntok) ? r_ : ntok - 1; \
            const bf16* p = HG + (size_t)(row0 + (long)(c) * 64 + rc) * 4096 + h * 128 + pc * 8; pq[e] = *(const v4u*)p; pk[e] = *(const v4u*)(p + 1024); pv[e] = *(const v4u*)(p + 2048); } \
        _Pragma("unroll") for (int hh = 0; hh < 2; ++hh) { const int r_ = 16 * ti + (lane >> 2); const int rc = (ntok >= 64 || r_ < ntok) ? r_ : ntok - 1; \
            pg[hh] = *(const v4u*)(HG + (size_t)(row0 + (long)(c) * 64 + rc) * 4096 + 3072 + h * 128 + 64 * vh + 8 * ((lane & 3) + 4 * hh)); } } while (0)
    HG_LOAD(0);
    for (int c = 0; c < nchunk; ++c) {
        float q[16], k[16]; unsigned vpk[8]; v4u gcur[2];
#pragma unroll
        for (int e = 0; e < 2; ++e) { const int id = tid + 512 * e, r_ = id >> 4, pc = id & 15;
            *(LAS v4u*)(Qt + r_ * QT_P + pc * 8) = pq[e]; *(LAS v4u*)(Kt + r_ * QT_P + pc * 8) = pk[e]; *(LAS v4u*)(RV + r_ * QT_P + pc * 8) = pv[e]; }
        gcur[0] = pg[0]; gcur[1] = pg[1];
        if (c + 1 < nchunk) HG_LOAD(c + 1);
        __syncthreads();
        { unsigned short rv[16];
#pragma unroll
          for (int i = 0; i < 16; ++i) { const bool ok = (ntok >= 64) || (16 * qt + i) < ntok; const int o_ = (16 * qt + i) * QT_P + kc;
              const unsigned short tq_ = Qt[o_], tk_ = Kt[o_], tv_ = RV[o_]; q[i] = ok ? bf2f(tq_) : 0.f; k[i] = ok ? bf2f(tk_) : 0.f; rv[i] = ok ? tv_ : (unsigned short)0; }
#pragma unroll
          for (int i = 0; i < 8; ++i) vpk[i] = (unsigned)rv[2 * i] | ((unsigned)rv[2 * i + 1] << 16); }
        float g[16]; float run = 1.f;
#pragma unroll
        for (int i = 0; i < 16; ++i) { run *= (1.0f - k[i]); g[i] = run; }
        bsum[qt * 128 + kc] = run;
        __syncthreads();
        float off = 1.f, tot = 1.f;
#pragma unroll
        for (int j = 0; j < 4; ++j) { const float s_ = bsum[j * 128 + kc]; tot *= s_; off *= (j < qt) ? s_ : 1.f; }
        unsigned khp[8];
#pragma unroll
        for (int i = 0; i < 16; i += 2) {
            const float p0 = off * g[i], p1 = off * g[i + 1]; const float r0 = __builtin_amdgcn_rcpf(p0), r1 = __builtin_amdgcn_rcpf(p1);
            const unsigned qq = pk2(q[i] * p0, q[i + 1] * p1), kk = pk2(k[i] * r0, k[i + 1] * r1);
            Qt[(16 * qt + i) * QT_P + kc] = (bf16)(qq & 0xffffu); Qt[(16 * qt + i + 1) * QT_P + kc] = (bf16)(qq >> 16);
            Kt[(16 * qt + i) * QT_P + kc] = (bf16)(kk & 0xffffu); Kt[(16 * qt + i + 1) * QT_P + kc] = (bf16)(kk >> 16);
            khp[i >> 1] = pk2(k[i] * (tot * r0), k[i + 1] * (tot * r1));
        }
        *(LAS v4u*)(KhT + kc * KH_P + 16 * qt) = (v4u){khp[0], khp[1], khp[2], khp[3]}; *(LAS v4u*)(KhT + kc * KH_P + 16 * qt + 8) = (v4u){khp[4], khp[5], khp[6], khp[7]};
        *(LAS v4u*)(VT + kc * KH_P + 16 * qt) = (v4u){vpk[0], vpk[1], vpk[2], vpk[3]}; *(LAS v4u*)(VT + kc * KH_P + 16 * qt + 8) = (v4u){vpk[4], vpk[5], vpk[6], vpk[7]};
        if (qt == 0) dlast[kc] = tot;
        __syncthreads();
        { bf16x8 af[4];
#pragma unroll
          for (int kk = 0; kk < 4; ++kk) af[kk] = *(const LAS bf16x8*)(Qt + (16 * ti + fr) * QT_P + 32 * kk + 8 * fq);
#pragma unroll
          for (int jj = 0; jj < 2; ++jj) { const int sj = 2 * vh + jj;
            f32x4 a = (f32x4){0.f, 0.f, 0.f, 0.f};
            if (sj <= ti) { bf16x8 bfr[4];
#pragma unroll
                for (int kk = 0; kk < 4; ++kk) bfr[kk] = *(const LAS bf16x8*)(Kt + (16 * sj + fr) * QT_P + 32 * kk + 8 * fq);
                __builtin_amdgcn_sched_barrier(0);
#pragma unroll
                for (int kk = 0; kk < 4; ++kk) a = HG_MFMA(af[kk], bfr[kk], a);
            }
#pragma unroll
            for (int i = 0; i < 4; ++i) { const int t = 16 * ti + 4 * fq + i, s_ = 16 * sj + fr; const float val = (s_ <= t) ? a[i] : 0.f; Am[t * KH_P + s_] = (bf16)(pk2(val, 0.f) & 0xffffu); }
          } }
        __syncthreads();
        f32x4 oacc[4];
        { bf16x8 aA[2], aQ[4], bb[2][6];
#pragma unroll
          for (int kk = 0; kk < 2; ++kk) aA[kk] = *(const LAS bf16x8*)(Am + (16 * ti + fr) * KH_P + 32 * kk + 8 * fq);
#pragma unroll
          for (int kk = 0; kk < 4; ++kk) aQ[kk] = *(const LAS bf16x8*)(Qt + (16 * ti + fr) * QT_P + 32 * kk + 8 * fq);
#define HG_LDB(dst, vt_) do { _Pragma("unroll") for (int kk = 0; kk < 2; ++kk) dst[kk] = *(const LAS bf16x8*)(VT + (16 * (vt_) + fr) * KH_P + 32 * kk + 8 * fq); \
              _Pragma("unroll") for (int kk = 0; kk < 4; ++kk) dst[2 + kk] = *(const LAS bf16x8*)(ST + (16 * (vt_) + fr) * ST_P + 32 * kk + 8 * fq); } while (0)
          HG_LDB(bb[0], 4 * vh);
#pragma unroll
          for (int j = 0; j < 4; ++j) { f32x4 o = (f32x4){0.f, 0.f, 0.f, 0.f};
              if (j + 1 < 4) HG_LDB(bb[(j + 1) & 1], 4 * vh + j + 1);
              __builtin_amdgcn_sched_barrier(0);
#pragma unroll
              for (int kk = 0; kk < 2; ++kk) o = HG_MFMA(aA[kk], bb[j & 1][kk], o);
#pragma unroll
              for (int kk = 0; kk < 4; ++kk) o = HG_MFMA(aQ[kk], bb[j & 1][2 + kk], o);
              oacc[j] = o; }
#undef HG_LDB
        }
#pragma unroll
        for (int i = 0; i < 4; ++i) { float p = 0.f;
#pragma unroll
            for (int j = 0; j < 4; ++j) p += oacc[j][i] * oacc[j][i];
            p += dpp_f<0xB1>(p); p += dpp_f<0x4E>(p); p += dpp_f<0x124>(p); p += dpp_f<0x128>(p);
            if (fr == 0) ssq[vh * 64 + 16 * ti + 4 * fq + i] = p; }
        __syncthreads();
#pragma unroll
        for (int i = 0; i < 4; ++i) { const int t = 16 * ti + 4 * fq + i; const float r = rsqrtf((ssq[t] + ssq[64 + t]) * (1.f / 128.f) + EPS);
#pragma unroll
            for (int j = 0; j < 4; ++j) ost[(4 * fq + i) * OST_P + 16 * j + fr] = (bf16)(pk2(oacc[j][i] * r * og[j], 0.f) & 0xffffu); }
        asm volatile("s_waitcnt lgkmcnt(0)" ::: "memory");
#pragma unroll
        for (int hh = 0; hh < 2; ++hh) { const int orow = lane >> 2, och = (lane & 3) + 4 * hh; const v4u w = *(const LAS v4u*)(ost + orow * OST_P + 8 * och); const v4u gg = gcur[hh];
            v4u o4; o4.x = pk2(bflo(w.x) * bflo(gg.x), bfhi(w.x) * bfhi(gg.x)); o4.y = pk2(bflo(w.y) * bflo(gg.y), bfhi(w.y) * bfhi(gg.y));
            o4.z = pk2(bflo(w.z) * bflo(gg.z), bfhi(w.z) * bfhi(gg.z)); o4.w = pk2(bflo(w.w) * bflo(gg.w), bfhi(w.w) * bfhi(gg.w));
            if (ntok >= 64 || 16 * ti + orow < ntok) *(v4u*)(OUT + (size_t)(row0 + (long)c * 64 + 16 * ti + orow) * DM + h * 128 + 64 * vh + 8 * och) = o4; }
        asm volatile("s_waitcnt lgkmcnt(0)" ::: "memory");
        { float d[4];
#pragma unroll
          for (int i = 0; i < 4; ++i) d[i] = dlast[16 * wid + 4 * fq + i];
          bf16x8 aK[2];
#pragma unroll
          for (int kk = 0; kk < 2; ++kk) aK[kk] = *(const LAS bf16x8*)(KhT + (16 * wid + fr) * KH_P + 32 * kk + 8 * fq);
#pragma unroll
          for (int g4 = 0; g4 < 2; ++g4) { bf16x8 bv[4][2];
#pragma unroll
              for (int u = 0; u < 4; ++u)
#pragma unroll
                  for (int kk = 0; kk < 2; ++kk) bv[u][kk] = *(const LAS bf16x8*)(VT + (16 * (4 * g4 + u) + fr) * KH_P + 32 * kk + 8 * fq);
              __builtin_amdgcn_sched_barrier(0);
#pragma unroll
              for (int u = 0; u < 4; ++u) { const int vt = 4 * g4 + u; f32x4 a = sacc[vt];
#pragma unroll
                  for (int i = 0; i < 4; ++i) a[i] *= d[i];
#pragma unroll
                  for (int kk = 0; kk < 2; ++kk) a = HG_MFMA(aK[kk], bv[u][kk], a);
                  sacc[vt] = a;
                  v2u w; w.x = pk2(a[0], a[1]); w.y = pk2(a[2], a[3]); *(LAS v2u*)(ST + (16 * vt + fr) * ST_P + 16 * wid + 4 * fq) = w; } } }
    }
#undef HG_LOAD
#pragma unroll
    for (int vt = 0; vt < 8; ++vt) {
#pragma unroll
        for (int i = 0; i < 4; ++i) Sout[(size_t)(16 * wid + 4 * fq + i) * 128 + 16 * vt + fr] = sacc[vt][i];
    }
    __syncthreads();
}
}

namespace sa {
constexpr int SCP = 1044, NQ = 8;
constexpr int L_Q = 0, L_SC = 8192, L_OACC = L_SC + NQ * SCP * 4, L_O0 = L_OACC + 4 * NQ * 128 * 4, L_END = L_O0 + NQ * 128 * 4;
static_assert(L_END <= RING_BYTES, "sample attention LDS");
__device__ __forceinline__ void item(LAS unsigned char* lds, int it2, const bf16* Qb, const bf16* Kb, const bf16* Vb, const float* ck, const float* cv, bf16* OC, float lam, const float* subg) {
    int tid_ = threadIdx.x; asm volatile("" : "+v"(tid_));
    const int tid = tid_, lane = tid & 63, wid = __builtin_amdgcn_readfirstlane(tid >> 6);
    const int it = it2 >> 1, q0 = (it2 & 1) * NQ, b = it >> 3, h = it & 7;
    LAS float* Qs = (LAS float*)(lds + L_Q); LAS float* SC = (LAS float*)(lds + L_SC); LAS float* OA = (LAS float*)(lds + L_OACC); LAS float* O0 = (LAS float*)(lds + L_O0);
    const size_t srow = (size_t)NP + (size_t)b * 16;
    __syncthreads();
    if (tid < 256) { const int idx = tid * 4, c = idx >> 9, qq = (idx >> 6) & 7, d = idx & 63;
      const v2u w = *(const v2u*)(Qb + (srow + q0 + qq) * DM + h * 128 + c * 64 + d);
      Qs[idx] = bflo(w.x); Qs[idx + 1] = bfhi(w.x); Qs[idx + 2] = bflo(w.y); Qs[idx + 3] = bfhi(w.y); }
    __syncthreads();
    for (int c = 0; c < 2; ++c) {
        for (int key = tid; key < 1040; key += 512) {
            float s[NQ];
            float kd[64];
            if (key < 1024) { const f32x4* kp = (const f32x4*)(ck + (((size_t)b * 1024 + key) * 8 + h) * 128 + c * 64);
#pragma unroll
                for (int j = 0; j < 16; ++j) { const f32x4 t4 = kp[j]; kd[4 * j] = t4.x; kd[4 * j + 1] = t4.y; kd[4 * j + 2] = t4.z; kd[4 * j + 3] = t4.w; } }
            else { const v4u* kp = (const v4u*)(Kb + (srow + (key - 1024)) * DM + h * 128 + c * 64);
#pragma unroll
                for (int j = 0; j < 8; ++j) { const v4u t4 = kp[j]; kd[8 * j] = bflo(t4.x); kd[8 * j + 1] = bfhi(t4.x); kd[8 * j + 2] = bflo(t4.y); kd[8 * j + 3] = bfhi(t4.y);
                    kd[8 * j + 4] = bflo(t4.z); kd[8 * j + 5] = bfhi(t4.z); kd[8 * j + 6] = bflo(t4.w); kd[8 * j + 7] = bfhi(t4.w); } }
#pragma unroll
            for (int qq = 0; qq < NQ; ++qq) { const LAS f32x4* qp = (const LAS f32x4*)(Qs + c * (NQ * 64) + qq * 64); float a = 0.f;
#pragma unroll
                for (int j = 0; j < 16; ++j) { const f32x4 q4 = qp[j]; a += (kd[4 * j] * q4.x + kd[4 * j + 1] * q4.y) + (kd[4 * j + 2] * q4.z + kd[4 * j + 3] * q4.w); }
                s[qq] = a; }
#pragma unroll
            for (int qq = 0; qq < NQ; ++qq) SC[qq * SCP + key] = s[qq];
        }
        __syncthreads();
        { LAS float* row = SC + wid * SCP;
            float mx = -INFINITY; for (int key = lane; key < 1040; key += 64) mx = fmaxf(mx, row[key]);
            mx = wave_max(mx);
            float sm = 0.f; for (int key = lane; key < 1040; key += 64) { const float p = exp2f(row[key] - mx); row[key] = p; sm += p; }
            sm = wave_sum(sm); const float inv = 1.0f / sm;
            for (int key = lane; key < 1040; key += 64) row[key] *= inv; }
        __syncthreads();
        { const int e = tid & 127, kq = wid >> 1; float acc[NQ];
#pragma unroll
          for (int qq = 0; qq < NQ; ++qq) acc[qq] = 0.f;
          for (int key = kq * 256; key < kq * 256 + 256; key += 16) {
              float v[16];
#pragma unroll
              for (int u = 0; u < 16; ++u) v[u] = cv[(((size_t)b * 1024 + key + u) * 8 + h) * 128 + e];
#pragma unroll
              for (int qq = 0; qq < NQ; ++qq) {
#pragma unroll
                  for (int u4 = 0; u4 < 4; ++u4) { const f32x4 p4 = *(const LAS f32x4*)(SC + qq * SCP + key + 4 * u4); acc[qq] += (p4.x * v[4 * u4] + p4.y * v[4 * u4 + 1]) + (p4.z * v[4 * u4 + 2] + p4.w * v[4 * u4 + 3]); } } }
          { const int key = 1024 + 4 * kq; float v[4];
#pragma unroll
              for (int u = 0; u < 4; ++u) v[u] = bf2f(Vb[(srow + (key + u - 1024)) * DM + h * 128 + e]);
#pragma unroll
              for (int qq = 0; qq < NQ; ++qq) { const f32x4 p4 = *(const LAS f32x4*)(SC + qq * SCP + key); acc[qq] += (p4.x * v[0] + p4.y * v[1]) + (p4.z * v[2] + p4.w * v[3]); } }
#pragma unroll
          for (int qq = 0; qq < NQ; ++qq) OA[(kq * NQ + qq) * 128 + e] = acc[qq]; }
        __syncthreads();
        { const int qq = wid, e0 = lane * 2; float v[2];
#pragma unroll
          for (int j = 0; j < 2; ++j) v[j] = (OA[(0 * NQ + qq) * 128 + e0 + j] + OA[(1 * NQ + qq) * 128 + e0 + j]) + (OA[(2 * NQ + qq) * 128 + e0 + j] + OA[(3 * NQ + qq) * 128 + e0 + j]);
          if (c == 0) { O0[qq * 128 + e0] = v[0]; O0[qq * 128 + e0 + 1] = v[1]; }
          else { const float o0 = O0[qq * 128 + e0] - lam * v[0], o1 = O0[qq * 128 + e0 + 1] - lam * v[1];
              const float s = wave_sum(o0 * o0 + o1 * o1);
              const float r = rsqrtf(s * (1.f / 128.f) + EPS) * (1.0f - LAM_INIT);
              *(unsigned*)(OC + (srow + q0 + qq) * DM + h * 128 + e0) = pk2(o0 * r * subg[e0], o1 * r * subg[e0 + 1]); } }
        __syncthreads();
    }
}
}

#define XB_TMO      128
#define XB_XCNT(j)  (256  + 64 * (j))
#define XB_XSUB(j)  (1280 + 64 * (j))
#define XB_XGEN(j)  (2304 + 64 * (j))
#define XB_TOP      3328
#define XB_TOPGEN   3392
#define XCD_BAR_WORDS 3456
#define XB_SPIN_CAP (1u << 18)

__device__ __forceinline__ unsigned xb_ld(unsigned* p)              { return __hip_atomic_load(p, __ATOMIC_RELAXED, __HIP_MEMORY_SCOPE_AGENT); }
__device__ __forceinline__ unsigned xb_add(unsigned* p, unsigned v) { return __hip_atomic_fetch_add(p, v, __ATOMIC_RELAXED, __HIP_MEMORY_SCOPE_AGENT); }
__device__ __forceinline__ unsigned xb_xcc_id() { return (unsigned)__builtin_amdgcn_s_getreg((3 << 11) | 20) & 0xFu; }
#define XB_SPIN(cond, bar) do { unsigned _sp = 0; while (cond) { __builtin_amdgcn_s_sleep(1); \
    if ((++_sp & 255u) == 0u) { if (xb_ld(&(bar)[XB_TMO])) break; if (_sp > XB_SPIN_CAP) { atomicAdd(&(bar)[XB_TMO], 1u); break; } } } } while (0)

struct XcdBarrier {
    unsigned* bar; unsigned x;
    volatile LAS unsigned* st;
};

__device__ __forceinline__ XcdBarrier xcd_barrier_post(unsigned* bar, volatile LAS unsigned* st) {
    XcdBarrier b; b.bar = bar; b.x = xb_xcc_id(); b.st = st;
    if (threadIdx.x == 0) (void)xb_add(&bar[XB_XCNT(b.x)], 1u);
    return b;
}
__device__ __forceinline__ void xcd_barrier_complete(unsigned* bar, unsigned x, unsigned& nloc, unsigned& nx) {
    const unsigned G = gridDim.x * gridDim.y * gridDim.z;
    unsigned sum, cnt, mine, sp = 0u;
    for (;;) {
        sum = 0u; cnt = 0u; mine = 0u;
#pragma unroll
        for (unsigned j = 0; j < 16; ++j) { const unsigned c = xb_ld(&bar[XB_XCNT(j)]); sum += c; cnt += (c > 0u) ? 1u : 0u; mine = (j == x) ? c : mine; }
        if (sum == G) break;
        __builtin_amdgcn_s_sleep(1);
        if ((++sp & 255u) == 0u) { if (xb_ld(&bar[XB_TMO])) break; if (sp > XB_SPIN_CAP) { atomicAdd(&bar[XB_TMO], 1u); break; } }
    }
    nloc = mine > 0u ? mine : 1u; nx = cnt > 0u ? cnt : 1u;
}

__device__ __forceinline__ void xcd_barrier(const XcdBarrier& b) {
    asm volatile("s_waitcnt vmcnt(0)" ::: "memory");
    __syncthreads();
    if (threadIdx.x == 0) {
        unsigned* bar = b.bar;
        __builtin_amdgcn_s_waitcnt(0);
        unsigned nloc = b.st[0], nx = b.st[1];
        if (nloc == 0u) { xcd_barrier_complete(bar, b.x, nloc, nx); b.st[0] = nloc; b.st[1] = nx; }
        const unsigned old = xb_add(&bar[XB_XSUB(b.x)], 1u);
        const unsigned gen = old / nloc;
        if (old + 1u == (gen + 1u) * nloc) {
            __builtin_amdgcn_fence(__ATOMIC_RELEASE, "agent");
            asm volatile("s_waitcnt vmcnt(0)" ::: "memory");
            const unsigned og = xb_add(&bar[XB_TOP], 1u);
            const unsigned tg = og / nx;
            if (og + 1u == (tg + 1u) * nx) xb_add(&bar[XB_TOPGEN], 1u);
            else XB_SPIN(xb_ld(&bar[XB_TOPGEN]) == tg, bar);
            __builtin_amdgcn_fence(__ATOMIC_ACQUIRE, "agent");
            xb_add(&bar[XB_XGEN(b.x)], 1u);
            asm volatile("s_waitcnt vmcnt(0)" ::: "memory");
        } else {
            XB_SPIN(xb_ld(&bar[XB_XGEN(b.x)]) == gen, bar);
            __builtin_amdgcn_fence(__ATOMIC_ACQUIRE, "agent");
            asm volatile("s_waitcnt vmcnt(0)" ::: "memory");
        }
    }
    __syncthreads();
}

__global__ void __launch_bounds__(NWAVES * 64, 2) yoco_fwd(Args args) {
    extern __shared__ __attribute__((aligned(16))) unsigned char lds[];
    cg::grid_group grid = cg::this_grid();
#define GRID_SYNC() xcd_barrier(xbar)
    volatile LAS unsigned* xb_st = (volatile LAS unsigned*)((LAS unsigned char*)lds + 155136);
    if (threadIdx.x < 2) xb_st[threadIdx.x] = 0u;
    __syncthreads();
    XcdBarrier xbar = xcd_barrier_post((unsigned*)args.ws, xb_st);
    grid.sync();
    Frame F;
    F.lds = (LAS unsigned char*)lds;
#define REFRESH() do { int t_ = threadIdx.x; asm volatile("" : "+v"(t_)); F.tid = t_; F.lane = t_ & 63; F.wave = __builtin_amdgcn_readfirstlane(t_ >> 6); } while (0)
    REFRESH();
    F.G = gridDim.x; { const int bx = blockIdx.x; F.vcu = (F.G % 8 == 0) ? (bx % 8) * (F.G / 8) + bx / 8 : bx; }
    unsigned char* ws = args.ws; float* out = args.out;
    const float* x_prompt = args.in[0]; const float* x_sample = args.in[1]; const float* cache_k = args.in[2]; const float* cache_v = args.in[3]; const float* state_hgrn = args.in[4];
    const float* norm_g = args.in[5]; const float* w_hgrn_in = args.in[6]; const float* lb_logits = args.in[7]; const float* onorm_g = args.in[8]; const float* w_hgrn_out = args.in[9];
    const float* kv_norm_g = args.in[10]; const float* w_kv = args.in[11]; const float* w_dq = args.in[12]; const float* diff_lambda = args.in[13]; const float* subln_g = args.in[14];
    const float* w_do = args.in[15]; const float* w_up = args.in[16]; const float* w_down = args.in[17];
    float* OML = (float*)(ws + WS_OML);
    bf16* Wt_in = (bf16*)(ws + WS_WIN); bf16* Wt_ho = (bf16*)(ws + WS_WHO); bf16* Wt_up0 = (bf16*)(ws + WS_WUP0); bf16* Wt_dn0 = (bf16*)(ws + WS_WDN0);
    bf16* Wt_qkv = (bf16*)(ws + WS_WQKV); bf16* Wt_do = (bf16*)(ws + WS_WDO); bf16* Wt_up1 = (bf16*)(ws + WS_WUP1); bf16* Wt_dn1 = (bf16*)(ws + WS_WDN1);
    bf16* XN = (bf16*)(ws + WS_XN); bf16* MB = (bf16*)(ws + WS_MB); bf16* R0 = (bf16*)(ws + WS_R0);
    bf16* QB = (bf16*)(ws + WS_Q); bf16* KB = (bf16*)(ws + WS_K); bf16* VB = (bf16*)(ws + WS_V); bf16* O1 = (bf16*)(ws + WS_O1); bf16* O2 = (bf16*)(ws + WS_O2); bf16* OC = QB; float* RS = (float*)(ws + WS_RS); float* PACC = (float*)(ws + WS_PACC);
    const int NGW = F.G * NWAVES;

    {
        const int gw = F.vcu * NWAVES + F.wave;
        LAS float* scr = (LAS float*)(F.lds + RING_OFF + F.wave * 16384);
        constexpr int I_SQ = (DM / 64) * (DM / 32), I_UP = (DM / 64) * (FF / 32), I_DN = (FF / 64) * (DM / 32), I_KV = (DM / 64) * (2 * DM / 32);
        constexpr int NITEMS = I_UP   + I_SQ   + 2 * I_UP + 2 * I_DN + I_SQ   + I_KV + I_SQ  ;
#define W_ITEM(it_) do { int r = (it_); \
            if (r < I_UP) { p0_transpose_item(w_hgrn_in, norm_g + 0 * DM, DM, FF, Wt_in, 0, scr, r, F.lane); break; } r -= I_UP; \
            if (r < I_SQ) { p0_transpose_item(w_hgrn_out, nullptr, DM, DM, Wt_ho, 0, scr, r, F.lane); break; } r -= I_SQ; \
            if (r < I_UP) { p0_transpose_item(w_up, norm_g + 2 * DM, DM, FF, Wt_up0, 0, scr, r, F.lane); break; } r -= I_UP; \
            if (r < I_UP) { p0_transpose_item(w_up + (size_t)DM * FF, norm_g + 6 * DM, DM, FF, Wt_up1, 0, scr, r, F.lane); break; } r -= I_UP; \
            if (r < I_DN) { p0_transpose_item(w_down, nullptr, FF, DM, Wt_dn0, 0, scr, r, F.lane); break; } r -= I_DN; \
            if (r < I_DN) { p0_transpose_item(w_down + (size_t)FF * DM, nullptr, FF, DM, Wt_dn1, 0, scr, r, F.lane); break; } r -= I_DN; \
            if (r < I_SQ) { p0_transpose_item(w_dq, norm_g + 4 * DM, DM, DM, Wt_qkv, 0, scr, r, F.lane); break; } r -= I_SQ; \
            if (r < I_KV) { p0_transpose_item(w_kv, kv_norm_g, DM, 2 * DM, Wt_qkv, DM, scr, r, F.lane); break; } r -= I_KV; \
            p0_transpose_item(w_do, nullptr, DM, DM, Wt_do, 0, scr, r, F.lane); } while (0)
        for (int it = gw; it < ((F.G > 192) ? I_UP : NITEMS); it += NGW) W_ITEM(it);
        if (blockIdx.x == 0) { for (int c = F.tid; c < DM; c += NWAVES * 64) { const float l0 = lb_logits[c], l1 = lb_logits[DM + c]; OML[c] = 1.0f / (1.0f + __expf(l0 - l1)); } }
        for (int m = gw; m < M; m += NGW) rms_row_to_bf16(m < NP ? x_prompt + (size_t)m * DM : x_sample + (size_t)(m - NP) * DM, XN + (size_t)m * DM, RS + m, F.lane);
    }
    GRID_SYNC(); if (STOP_AFTER == 0) return;

    {
        pg8::Gemm g{XN, Wt_in, M, FF, DM}; pg8::StaticOrder S; S.init(M, FF, F.G, (int)blockIdx.x);
        pg8::EpiAct<2> E{R0, FF, OML, nullptr, nullptr, 0, 1.f};
        pg8::gemm_phase<pg8::EpiAct<2>, pg8::StaticOrder, PG8_ALIGN, PG8_SP2>(F.lds + RING_OFF, g, S, E);
    }
    GRID_SYNC(); if (STOP_AFTER == 1) { REFRESH(); for (int row = F.vcu * NWAVES + F.wave; row < NP; row += NGW) for (int c = F.lane; c < DM; c += 64) { out[(size_t)row * DM + c] = bf2f(R0[(size_t)row * FF + c]); out[O_KP + (size_t)row * DM + c] = bf2f(R0[(size_t)row * FF + 3072 + c]); } return; }

    if ((int)blockIdx.x >= 192) {
        REFRESH();
        LAS float* scr = (LAS float*)(F.lds + RING_OFF + F.wave * 16384);
        constexpr int I_SQ = (DM / 64) * (DM / 32), I_UP = (DM / 64) * (FF / 32), I_DN = (FF / 64) * (DM / 32), I_KV = (DM / 64) * (2 * DM / 32);
        constexpr int NITEMS = I_UP + I_SQ + 2 * I_UP + 2 * I_DN + I_SQ + I_KV + I_SQ;
        const int nidle = ((int)F.G - 192) * NWAVES;
        for (int it = I_UP + ((int)blockIdx.x - 192) * NWAVES + F.wave; it < NITEMS; it += nidle) W_ITEM(it);
    }
    for (int it = blockIdx.x; it < 64 + 128; it += F.G) {
        if (it < 64) { const int b = it >> 3, h = it & 7;
            hg::hgrn_item<64>(F.lds + RING_OFF, R0, O2, nullptr, out + O_STP + (size_t)it * 16384, (long)b * 8192, 128, h, onorm_g); }
        else { const int is = it - 64, b = is >> 3, h = is & 7;
            hg::hgrn_item<16>(F.lds + RING_OFF, R0, O2, state_hgrn + (size_t)is * 16384, out + O_STS + (size_t)is * 16384, (long)NP + b * 16, 1, h, onorm_g); }
    }
    GRID_SYNC(); if (STOP_AFTER == 2) { REFRESH(); for (int row = F.vcu * NWAVES + F.wave; row < M; row += NGW) for (int c = F.lane; c < DM; c += 64) out[(size_t)row * DM + c] = bf2f(XN[(size_t)row * DM + c]) - bf2f(MB[(size_t)row * DM + c]);
        for (size_t i = (size_t)blockIdx.x * 512 + F.tid; i < (size_t)192 * 16384; i += (size_t)F.G * 512) { const float a = (i < (size_t)64 * 16384) ? out[O_STP + i] : out[O_STS + i - (size_t)64 * 16384]; out[(size_t)1024 * DM + i] = a - ((const float*)(ws + 900 * MiB))[i]; }
        return; }

    {
        pg8::Gemm g{O2, Wt_ho, M, DM, DM}; pg8::StaticOrder S; S.init(M, DM, F.G, (int)blockIdx.x, DM, SPLK);
        pg8::EpiAct<0> E{MB, DM, nullptr, nullptr, nullptr, 0, 1.f, PACC};
        pg8::gemm_phase<pg8::EpiAct<0>, pg8::StaticOrder, PG8_ALIGN, PG8_SP2>(F.lds + RING_OFF, g, S, E);
    }
    GRID_SYNC(); if (STOP_AFTER == 3) { REFRESH(); for (int row = F.vcu * NWAVES + F.wave; row < M; row += NGW) for (int c = F.lane; c < DM; c += 64) out[(size_t)row * DM + c] = bf2f(MB[(size_t)row * DM + c]); return; }
    REFRESH(); norm_phase<false>(F, MB, PACC, norm_g + 1 * DM, RS, out, XN);
    GRID_SYNC(); if (STOP_AFTER == 4) return;
    {
        pg8::Gemm g{XN, Wt_up0, M, FF, DM}; pg8::StaticOrder S; S.init(M, FF, F.G, (int)blockIdx.x);
        pg8::EpiAct<1> E{R0, FF, nullptr, nullptr, nullptr, 0, 1.f};
        pg8::gemm_phase<pg8::EpiAct<1>, pg8::StaticOrder, PG8_ALIGN, PG8_SP2>(F.lds + RING_OFF, g, S, E);
    }
    GRID_SYNC(); if (STOP_AFTER == 5) return;
    {
        pg8::Gemm g{R0, Wt_dn0, M, DM, FF}; pg8::StaticOrder S; S.init(M, DM, F.G, (int)blockIdx.x, FF, SPLK);
        pg8::EpiAct<0> E{MB, DM, nullptr, nullptr, nullptr, 0, 1.f, PACC};
        pg8::gemm_phase<pg8::EpiAct<0>, pg8::StaticOrder, PG8_ALIGN, PG8_SP2>(F.lds + RING_OFF, g, S, E);
    }
    GRID_SYNC(); if (STOP_AFTER == 6) return;
    REFRESH(); norm_phase<false>(F, MB, PACC, norm_g + 3 * DM, RS, out, XN);
    GRID_SYNC(); if (STOP_AFTER == 7) return;
    {
        pg8::Gemm g{XN, Wt_qkv, M, 3 * DM, DM}; pg8::StaticOrder S; S.init(M, 3 * DM, F.G, (int)blockIdx.x);
        pg8::EpiAct<3> E{QB, DM, nullptr, out + O_KP, out + O_KS, (size_t)(WS_K - WS_Q) / 2, attn_body::C2};
        pg8::gemm_phase<pg8::EpiAct<3>, pg8::StaticOrder, PG8_ALIGN, PG8_SP2>(F.lds + RING_OFF, g, S, E);
    }
    GRID_SYNC(); if (STOP_AFTER == 8) return;
    {
        const attn_body::AttnTensors AT{(const attn_body::bf16*)QB, (const attn_body::bf16*)KB, (const attn_body::bf16*)VB, (attn_body::bf16*)O1, (attn_body::bf16*)O2};
        const attn_body::StaticOrder S((int)F.G, (int)blockIdx.x);
        attn_body::attn_phase<attn_body::StaticOrder>((char*)lds + RING_OFF, AT, S);
        asm volatile("s_waitcnt vmcnt(0) lgkmcnt(0)" ::: "memory"); __syncthreads();
        REFRESH(); const float lam = compute_lam(diff_lambda, F.lane);
        for (int it = F.vcu; it < 256; it += F.G) sa::item(F.lds + RING_OFF, it, QB, KB, VB, cache_k, cache_v, OC, lam, subln_g);
    }
    GRID_SYNC(); if (STOP_AFTER == 9) return;
    REFRESH(); combine_phase(F, O1, O2, diff_lambda, subln_g, OC);
    GRID_SYNC(); if (STOP_AFTER == 10) return;
    {
        pg8::Gemm g{OC, Wt_do, M, DM, DM}; pg8::StaticOrder S; S.init(M, DM, F.G, (int)blockIdx.x, DM, SPLK);
        pg8::EpiAct<0> E{MB, DM, nullptr, nullptr, nullptr, 0, 1.f, PACC};
        pg8::gemm_phase<pg8::EpiAct<0>, pg8::StaticOrder, PG8_ALIGN, PG8_SP2>(F.lds + RING_OFF, g, S, E);
    }
    GRID_SYNC(); if (STOP_AFTER == 11) return;
    REFRESH(); norm_phase<false>(F, MB, PACC, norm_g + 5 * DM, RS, out, XN);
    GRID_SYNC(); if (STOP_AFTER == 12) return;
    {
        pg8::Gemm g{XN, Wt_up1, M, FF, DM}; pg8::StaticOrder S; S.init(M, FF, F.G, (int)blockIdx.x);
        pg8::EpiAct<1> E{R0, FF, nullptr, nullptr, nullptr, 0, 1.f};
        pg8::gemm_phase<pg8::EpiAct<1>, pg8::StaticOrder, PG8_ALIGN, PG8_SP2>(F.lds + RING_OFF, g, S, E);
    }
    GRID_SYNC(); if (STOP_AFTER == 13) return;
    {
        pg8::Gemm g{R0, Wt_dn1, M, DM, FF}; pg8::StaticOrder S; S.init(M, DM, F.G, (int)blockIdx.x, FF, SPLK);
        pg8::EpiAct<0> E{MB, DM, nullptr, nullptr, nullptr, 0, 1.f, PACC};
        pg8::gemm_phase<pg8::EpiAct<0>, pg8::StaticOrder, PG8_ALIGN, PG8_SP2>(F.lds + RING_OFF, g, S, E);
    }
    GRID_SYNC(); if (STOP_AFTER == 14) return;
    REFRESH(); norm_phase<true>(F, MB, PACC, norm_g + 7 * DM, RS, out, XN);
}

extern "C" void kernel_launch(void* const* d_in, const int* in_sizes, int n_in, void* d_out, int out_size, void* d_ws, size_t ws_size, hipStream_t stream) {
    static int grid = 0;
    if (grid == 0) {
        if (n_in != 18 || in_sizes[0] != NP * DM || (size_t)out_size != O_END || ws_size < WS_END) {
            fprintf(stderr, "kernel_launch: shape mismatch: n_in %d in0 %d out %d ws %zu (need out %zu ws %zu); nothing launched\n", n_in, n_in > 0 ? in_sizes[0] : -1, out_size, ws_size, (size_t)O_END, (size_t)WS_END); grid = -1; return; }
        int dev = 0, cus = 0, per_cu = 0;
        if (hipGetDevice(&dev) != hipSuccess || hipDeviceGetAttribute(&cus, hipDeviceAttributeMultiprocessorCount, dev) != hipSuccess) { fprintf(stderr, "kernel_launch: device query failed\n"); grid = -1; return; }
        if (hipFuncSetAttribute((const void*)yoco_fwd, hipFuncAttributeMaxDynamicSharedMemorySize, LDS_BYTES) != hipSuccess) { fprintf(stderr, "kernel_launch: hipFuncSetAttribute failed\n"); grid = -1; return; }
        if (hipOccupancyMaxActiveBlocksPerMultiprocessor(&per_cu, (const void*)yoco_fwd, NWAVES * 64, LDS_BYTES) != hipSuccess || per_cu < 1) { fprintf(stderr, "kernel_launch: occupancy query says %d\n", per_cu); per_cu = 1; }
        (void)hipGetLastError();
        grid = cus;
    }
    if (grid < 0) return;
    if (hipMemsetAsync(d_ws, 0, 16384, stream) != hipSuccess) { fprintf(stderr, "kernel_launch: memset failed\n"); return; }
    Args a{};
    for (int i = 0; i < 18; ++i) a.in[i] = (const float*)d_in[i];
    a.out = (float*)d_out; a.ws = (unsigned char*)d_ws;
    void* kargs[] = {&a};
    hipError_t e = hipLaunchCooperativeKernel((const void*)yoco_fwd, dim3(grid), dim3(NWAVES * 64), kargs, LDS_BYTES, stream);
    if (e != hipSuccess) fprintf(stderr, "kernel_launch: cooperative launch failed: %s (grid %d)\n", hipGetErrorString(e), grid);
}
```

```cpp
#include <hip/hip_runtime.h>
#include <cstdio>
#include <cstdint>
namespace pg8 {
#define PG8_LAS __attribute__((address_space(3)))
typedef unsigned short bf16_t;
typedef short bf16x8 __attribute__((ext_vector_type(8)));
typedef float f32x4 __attribute__((ext_vector_type(4)));
typedef unsigned u32x4 __attribute__((ext_vector_type(4)));
constexpr int BM = 256, BK = 64, HALF = 128, HTB = HALF * BK * 2  , STAGE_BYTES = 8 * HTB, NXCD = 8, WGM = 8;

__host__ __device__ __forceinline__ int lds_byte(int r, int c) { const int st = (r >> 4) * 2 + (c >> 5), rr = r & 15, cc = c & 31, ob = rr * 64 + cc * 2; return st * 1024 + (ob ^ (((ob >> 9) & 1) << 5)); }
__host__ __device__ __forceinline__ void stage_rc(int b, int& R, int& C) { const int st = b / 1024, sb = b % 1024, swz = sb ^ (((sb >> 9) & 1) << 5); R = (st >> 1) * 16 + swz / 64; C = (st & 1) * 32 + (swz % 64) / 2; }
__host__ __device__ __forceinline__ int perm32(int rho) { const int n = rho >> 4, i = rho & 15; return 8 * (i >> 2) + 4 * n + (i & 3); }

struct Unit { int pm, pn; };
struct Gemm { const bf16_t* A; const bf16_t* Bt; int M, N, K; };

struct StaticOrder {
    int nM, nN, nwg, G, c, spl, nfull, ntk;
    __host__ __device__ __forceinline__ void init(int M, int N, int G_, int c_, int K = 0, int spl_ = 1) { nM = M / BM; nN = N / BM; G = G_; c = c_; spl = spl_; ntk = K / BK;
        if (spl > 1) { nM -= 1; nfull = nM * nN; nwg = nfull + nN * spl; } else { nfull = nwg = nM * nN; } }
    __host__ __device__ __forceinline__ bool next(int i, Unit& u) const {
        const long L = (long)i * G + c; if (L >= nwg) return false;
        if (L >= nfull) { const int j = (int)(L - nfull); u.pm = nM; u.pn = (j % nN) | ((j / nN + 1) << 8); return true; }
        int wgid = (int)L; { const int q = nfull / NXCD, r = nfull % NXCD, xcd = wgid % NXCD, off = wgid / NXCD; wgid = (xcd < r ? xcd * (q + 1) : r * (q + 1) + (xcd - r) * q) + off; }
        const int nig = WGM * nN, gid = wgid / nig, fm = gid * WGM, gsz = (nM - fm) < WGM ? (nM - fm) : WGM;
        u.pm = fm + ((wgid % nig) % gsz); u.pn = (wgid % nig) / gsz; return true;
    }
    __device__ __forceinline__ void a_ready(const Unit&) const {}
    __device__ __forceinline__ void done(const Unit&) const {}
};
typedef float cvt_f32x2_t __attribute__((ext_vector_type(2))); typedef __bf16 cvt_bf16x2_t __attribute__((ext_vector_type(2)));
__device__ __forceinline__ unsigned cvt_pk_bf16(float lo, float hi) { cvt_f32x2_t v = {lo, hi}; cvt_bf16x2_t b = __builtin_convertvector(v, cvt_bf16x2_t); return __builtin_bit_cast(unsigned, b); }
typedef float f32x2 __attribute__((ext_vector_type(2)));

typedef unsigned u32x4 __attribute__((ext_vector_type(4)));
__device__ __forceinline__ float fast_rcp(float x) { return __builtin_amdgcn_rcpf(x); }
__device__ __forceinline__ float silu_f(float x) { return x * fast_rcp(1.0f + __expf(-x)); }
template <int MODE> struct EpiAct {
    static constexpr bool PERM = true, AFTER_DRAIN = false;
    bf16_t* O; int ldc; const float* aux; float* kvp; float* kvs; size_t split_stride; float scale0; float* pacc = nullptr;
    __device__ __forceinline__ void operator()(const f32x4 (&acc)[2][2][4][2], const Unit& u, int wr, int wc, int fr, int fq) const {
        const int row0 = u.pm * BM + wr * 64 + fr;
        const int upn = u.pn & 255, upart = u.pn >> 8; int colt = upn * BM; bf16_t* base = O; float* fbase = nullptr; int type = 0;
        if (MODE == 2) type = upn >> 2;
        if (MODE == 3) { type = upn >> 2; colt -= type * 1024; base = O + (size_t)type * split_stride;
            if (type > 0) { fbase = (u.pm < 256) ? kvp + (size_t)(type - 1) * (65536u * 1024u) : (kvs + (size_t)(type - 1) * (256u * 1024u)) - (size_t)65536 * 1024; } }
        const int col0 = colt + wc * 32 + 8 * fq;
        f32x4 av[2][2];
        if (MODE == 2) {
#pragma unroll
            for (int bj = 0; bj < 2; ++bj)
#pragma unroll
                for (int n = 0; n < 2; ++n) av[bj][n] = (type == 1) ? *(const f32x4*)(aux + ((col0 + bj * HALF + 4 * n) & 1023)) : (f32x4){0.f, 0.f, 0.f, 0.f};
        }
#pragma unroll
        for (int ai = 0; ai < 2; ++ai)
#pragma unroll
            for (int m = 0; m < 4; ++m) { const size_t roff = (size_t)(row0 + ai * HALF + m * 16) * ldc + col0; bf16_t* rowp = base + roff;
#pragma unroll
                for (int bj = 0; bj < 2; ++bj) { f32x4 v0 = acc[ai][bj][m][0], v1 = acc[ai][bj][m][1];
                    if (MODE == 0 && upart != 0) { float* fp = pacc + (size_t)(upart - 1) * (256u * 1024u) + (size_t)(wr * 64 + fr + ai * HALF + m * 16) * ldc + col0 + bj * HALF; *(f32x4*)fp = v0; *(f32x4*)(fp + 4) = v1; continue; }
                    if (MODE == 1) {
#pragma unroll
                        for (int e = 0; e < 4; ++e) { const float a = fmaxf(v0[e], 0.f), b = fmaxf(v1[e], 0.f); v0[e] = a * a; v1[e] = b * b; } }
                    if (MODE == 2) {
                        if (type == 0 || type == 3) {
#pragma unroll
                            for (int e = 0; e < 4; ++e) { v0[e] = silu_f(v0[e]); v1[e] = silu_f(v1[e]); } }
                        else if (type == 1) {
#pragma unroll
                            for (int e = 0; e < 4; ++e) { v0[e] = av[bj][0][e] * fast_rcp(1.0f + __expf(v0[e])); v1[e] = av[bj][1][e] * fast_rcp(1.0f + __expf(v1[e])); } }
                    }
                    if (MODE == 3) {
                        if (type == 0) { v0 = v0 * scale0; v1 = v1 * scale0; }
                        else { float* fp = fbase + roff + bj * HALF; *(f32x4*)fp = v0; *(f32x4*)(fp + 4) = v1; }
                    }
                    u32x4 w; w.x = cvt_pk_bf16(v0[0], v0[1]); w.y = cvt_pk_bf16(v0[2], v0[3]); w.z = cvt_pk_bf16(v1[0], v1[1]); w.w = cvt_pk_bf16(v1[2], v1[3]);
                    *(u32x4*)(rowp + bj * HALF) = w; } }
    }
};

template <class Epi, class Sched, bool ALIGN_EPI = false, bool SP2 = false>
__device__ __forceinline__ void gemm_phase(PG8_LAS unsigned char* lds, const Gemm g, const Sched& S, const Epi& E) {
    int tid_ = threadIdx.x; asm volatile("" : "+v"(tid_));
    const int tid = tid_, wid = __builtin_amdgcn_readfirstlane(tid >> 6), lane = tid & 63, wr = wid >> 2, wc = wid & 3, fr = lane & 15, fq = lane >> 4;
    const int K = g.K, nt = K / BK;
    unsigned voffA[2], voffB[2];
#pragma unroll
    for (int i = 0; i < 2; ++i) { int R, C; stage_rc(tid * 16 + i * 8192, R, C); const int Rb = Epi::PERM ? ((R & ~31) + perm32(R & 31)) : R;
        voffA[i] = (unsigned)(R * K + C) * 2u; voffB[i] = (unsigned)(Rb * K + C) * 2u; }
    const size_t kstep = (size_t)(BK * 2);
    const size_t hstep = (size_t)HALF * K * 2;
    const size_t tstep = 2 * hstep;
    const unsigned ldsw = (unsigned)wid * 1024u;
    const int aoff = lds_byte(wr * 64 + fr, fq * 8), boff = lds_byte(wc * 32 + fr, fq * 8);
#define PG8_SA(b, h) (((b) * 2 + (h)) * HTB)
#define PG8_SB(b, h) ((4 + (b) * 2 + (h)) * HTB)
#define PG8_STAGE(bufoff, gbase, voff) do { _Pragma("unroll") for (int _i = 0; _i < 2; ++_i) \
        __builtin_amdgcn_global_load_lds((const unsigned*)((const char*)(gbase) + (voff)[_i]), (PG8_LAS unsigned*)(lds + (bufoff) + ldsw + _i * 8192), 16, 0, 0); } while (0)
#define PG8_LDA(dst, b, h) do { _Pragma("unroll") for (int m = 0; m < 4; ++m) _Pragma("unroll") for (int k = 0; k < 2; ++k) dst[m][k] = *(const PG8_LAS bf16x8*)(lds + PG8_SA(b, h) + aoff + m * 2048 + k * 1024); } while (0)
#define PG8_LDB(dst, b, h) do { _Pragma("unroll") for (int n = 0; n < 2; ++n) _Pragma("unroll") for (int k = 0; k < 2; ++k) dst[n][k] = *(const PG8_LAS bf16x8*)(lds + PG8_SB(b, h) + boff + n * 2048 + k * 1024); } while (0)
#define PG8_MMA(ai, bj, At, Bt) do { __builtin_amdgcn_s_setprio(1); _Pragma("unroll") for (int m = 0; m < 4; ++m) _Pragma("unroll") for (int n = 0; n < 2; ++n) _Pragma("unroll") for (int k = 0; k < 2; ++k) \
        acc[ai][bj][m][n] = __builtin_amdgcn_mfma_f32_16x16x32_bf16(Bt[n][k], At[m][k], acc[ai][bj][m][n], 0, 0, 0); __builtin_amdgcn_s_setprio(0); } while (0)
#define PG8_WAIT_V(n) asm volatile("s_waitcnt vmcnt(" #n ")" ::: "memory")
#define PG8_WAIT_L(n) asm volatile("s_waitcnt lgkmcnt(" #n ")" ::: "memory")
#define PG8_BAR __builtin_amdgcn_s_barrier()
#define PG8_SCHED __builtin_amdgcn_sched_barrier(0)
    Unit cur, nxt; int ui = 0;
    if (!S.next(0, cur)) return;
    const int nktp = S.spl > 1 ? S.ntk / S.spl : nt;
#define PG8_NT(u) (((u).pn >> 8) ? nktp : nt)
#define PG8_K0(u) ((size_t)(((u).pn >> 8) ? (((u).pn >> 8) - 1) * nktp : 0) * kstep)
    int ntc = PG8_NT(cur);
    f32x4 acc[2][2][4][2];
#pragma unroll
    for (int a = 0; a < 2; ++a)
#pragma unroll
        for (int b = 0; b < 2; ++b)
#pragma unroll
            for (int m = 0; m < 4; ++m)
#pragma unroll
                for (int n = 0; n < 2; ++n) acc[a][b][m][n] = (f32x4){0.f, 0.f, 0.f, 0.f};
    bf16x8 At[4][2], B0[2][2], B1[2][2];
    const char* cA = (const char*)g.A + (size_t)cur.pm * tstep + PG8_K0(cur); const char* cB = (const char*)g.Bt + (size_t)(cur.pn & 255) * tstep + PG8_K0(cur);
    S.a_ready(cur);
    if constexpr (SP2) {
        PG8_STAGE(PG8_SB(0, 0), cB, voffB); PG8_STAGE(PG8_SB(0, 1), cB + hstep, voffB); PG8_STAGE(PG8_SA(0, 0), cA, voffA); PG8_STAGE(PG8_SA(0, 1), cA + hstep, voffA);
        if (wr == 1) PG8_BAR;
        PG8_WAIT_V(2); PG8_BAR;
        PG8_STAGE(PG8_SB(1, 0), cB + kstep, voffB); PG8_STAGE(PG8_SA(1, 0), cA + kstep, voffA); PG8_STAGE(PG8_SB(1, 1), cB + hstep + kstep, voffB);
        PG8_WAIT_V(6); PG8_BAR;
    } else {
        PG8_STAGE(PG8_SB(0, 0), cB, voffB); PG8_STAGE(PG8_SA(0, 0), cA, voffA); PG8_STAGE(PG8_SB(0, 1), cB + hstep, voffB); PG8_STAGE(PG8_SA(0, 1), cA + hstep, voffA);
        if (wr == 1) PG8_BAR;
        PG8_WAIT_V(4); PG8_BAR;
        PG8_STAGE(PG8_SB(1, 0), cB + kstep, voffB); PG8_STAGE(PG8_SA(1, 0), cA + kstep, voffA); PG8_STAGE(PG8_SB(1, 1), cB + hstep + kstep, voffB);
        PG8_WAIT_V(6); PG8_BAR;
    }
    for (;;) {
        const bool has_next = S.next(ui + 1, nxt);
        const char* nA = has_next ? (const char*)g.A + (size_t)nxt.pm * tstep + PG8_K0(nxt) : cA; const char* nB = has_next ? (const char*)g.Bt + (size_t)(nxt.pn & 255) * tstep + PG8_K0(nxt) : cB;
        for (int t = 0; t < ntc; t += 2) {
            const bool last = (t == ntc - 2);
            const char* a1 = cA + (size_t)(t + 1) * kstep;
            const char* a2 = last ? nA : cA + (size_t)(t + 2) * kstep; const char* b2 = last ? nB : cB + (size_t)(t + 2) * kstep;
            const char* a3 = a2 + kstep; const char* b3 = b2 + kstep;
            if (last && has_next) S.a_ready(nxt);
            if constexpr (SP2) {
            PG8_LDB(B0, 0, 0); PG8_LDB(B1, 0, 1); PG8_SCHED; PG8_LDA(At, 0, 0); PG8_STAGE(PG8_SA(1, 1), a1 + hstep, voffA);
            PG8_WAIT_V(8); PG8_WAIT_L(0); PG8_BAR; PG8_MMA(0, 0, At, B0); PG8_MMA(0, 1, At, B1); PG8_BAR; PG8_SCHED;
            PG8_LDA(At, 0, 1); PG8_STAGE(PG8_SB(0, 0), b2, voffB); PG8_STAGE(PG8_SB(0, 1), b2 + hstep, voffB); PG8_STAGE(PG8_SA(0, 0), a2, voffA);
            PG8_WAIT_V(8); PG8_WAIT_L(0); PG8_BAR; PG8_MMA(1, 0, At, B0); PG8_MMA(1, 1, At, B1); PG8_BAR; PG8_SCHED;
            PG8_LDB(B0, 1, 0); PG8_LDB(B1, 1, 1); PG8_SCHED; PG8_LDA(At, 1, 0); PG8_STAGE(PG8_SA(0, 1), a2 + hstep, voffA);
            PG8_WAIT_V(8); PG8_WAIT_L(0); PG8_BAR; PG8_MMA(0, 0, At, B0); PG8_MMA(0, 1, At, B1); PG8_BAR; PG8_SCHED;
            PG8_LDA(At, 1, 1); PG8_STAGE(PG8_SB(1, 0), b3, voffB); PG8_STAGE(PG8_SB(1, 1), b3 + hstep, voffB); PG8_STAGE(PG8_SA(1, 0), a3, voffA);
            PG8_WAIT_V(8); PG8_WAIT_L(0); PG8_BAR; PG8_MMA(1, 0, At, B0); PG8_MMA(1, 1, At, B1); PG8_BAR; PG8_SCHED;
            } else {
            PG8_LDB(B0, 0, 0); PG8_SCHED; PG8_LDA(At, 0, 0); PG8_STAGE(PG8_SA(1, 1), a1 + hstep, voffA);
            PG8_WAIT_L(8); PG8_BAR; PG8_WAIT_L(0); PG8_MMA(0, 0, At, B0); PG8_BAR; PG8_SCHED;
            PG8_LDB(B1, 0, 1); PG8_STAGE(PG8_SB(0, 0), b2, voffB);
            PG8_BAR; PG8_WAIT_L(0); PG8_MMA(0, 1, At, B1); PG8_BAR;
            PG8_LDA(At, 0, 1); PG8_STAGE(PG8_SA(0, 0), a2, voffA);
            PG8_BAR; PG8_WAIT_L(0); PG8_MMA(1, 0, At, B0); PG8_BAR; PG8_SCHED;
            PG8_STAGE(PG8_SB(0, 1), b2 + hstep, voffB);
            PG8_WAIT_V(6); PG8_BAR; PG8_MMA(1, 1, At, B1); PG8_BAR;
            PG8_LDB(B0, 1, 0); PG8_SCHED; PG8_LDA(At, 1, 0); PG8_STAGE(PG8_SA(0, 1), a2 + hstep, voffA);
            PG8_WAIT_L(8); PG8_BAR; PG8_WAIT_L(0); PG8_MMA(0, 0, At, B0); PG8_BAR; PG8_SCHED;
            PG8_LDB(B1, 1, 1); PG8_STAGE(PG8_SB(1, 0), b3, voffB);
            PG8_BAR; PG8_WAIT_L(0); PG8_MMA(0, 1, At, B1); PG8_BAR;
            PG8_LDA(At, 1, 1); PG8_STAGE(PG8_SA(1, 0), a3, voffA);
            PG8_BAR; PG8_WAIT_L(0); PG8_MMA(1, 0, At, B0); PG8_BAR; PG8_SCHED;
            PG8_STAGE(PG8_SB(1, 1), b3 + hstep, voffB);
            PG8_WAIT_V(6); PG8_BAR; PG8_MMA(1, 1, At, B1); PG8_BAR;
            }
        }
        if constexpr (ALIGN_EPI) { if (wr == 0) PG8_BAR; }
        if constexpr (!Epi::AFTER_DRAIN) { E(acc, cur, wr, wc, fr, fq); S.done(cur); }
        if (!has_next) break;
#pragma unroll
        for (int a = 0; a < 2; ++a)
#pragma unroll
            for (int b = 0; b < 2; ++b)
#pragma unroll
                for (int m = 0; m < 4; ++m)
#pragma unroll
                    for (int n = 0; n < 2; ++n) acc[a][b][m][n] = (f32x4){0.f, 0.f, 0.f, 0.f};
        cur = nxt; cA = nA; cB = nB; ++ui; ntc = PG8_NT(cur);
        if constexpr (ALIGN_EPI) { if (wr == 1) PG8_BAR; }
    }
    PG8_WAIT_V(0);
    if constexpr (!ALIGN_EPI) { if (wr == 0) PG8_BAR; }
    PG8_BAR;
    if constexpr (Epi::AFTER_DRAIN) { E.fused(acc, cur, wr, wc, fr, fq, lds, wid, lane); S.done(cur); }
#undef PG8_SA
#undef PG8_SB
#undef PG8_STAGE
#undef PG8_LDA
#undef PG8_LDB
#undef PG8_MMA
#undef PG8_WAIT_V
#undef PG8_WAIT_L
#undef PG8_BAR
#undef PG8_SCHED
#undef PG8_NT
#undef PG8_K0
}
}
#define PG8_SP2 true
#define PG8_ALIGN true
#include <hip/hip_bf16.h>
#include <cmath>
namespace attn_body {
using bf16=__hip_bfloat16;
using bf16x8=__attribute__((ext_vector_type(8)))short;
using s16x4=__attribute__((ext_vector_type(4)))short;
using f32x16=__attribute__((ext_vector_type(16)))float;
using u32x4=__attribute__((ext_vector_type(4)))unsigned;
constexpr int BATCH=8,NHEAD=16,SEQ=8192,D=64,DM=NHEAD*D;
constexpr int NW=8,QBLK=32,QB=QBLK*NW,KVBLK=64,NQB=SEQ/QB;
constexpr int ATTN_PITCH=DM, ATTN_UNIT_ROWS=QB;
__device__ __forceinline__ int crow(int r,int hi){return (r&3)+8*(r>>2)+4*hi;}
#define SBAR() __builtin_amdgcn_sched_barrier(0)
__device__ __forceinline__ void cmask(f32x16&p0,f32x16&p1,int jb,int qrel,int hi){
  const float NEG=-INFINITY; (void)hi;
  if(jb>(qrel>>6)){
  #pragma unroll
  for(int r=0;r<16;++r){p0[r]=NEG;p1[r]=NEG;} }
}

constexpr int NSLOT=3, SLOTB=8192;
constexpr int LDS_K=0, LDS_V=NSLOT*SLOTB, LDS_WS=2*NSLOT*SLOTB, LDS_OST=LDS_WS+NW*64*4, LDS_BYTES=LDS_OST+NW*4096;
constexpr float C2=0.125f*1.4426950408889634f;
__device__ __forceinline__ void glds16(const void*gsrc,unsigned lds_dst){unsigned keep;
  asm volatile("s_mov_b32 %0, m0\n\ts_mov_b32 m0, %2\n\ts_nop 0\n\tglobal_load_lds_dwordx4 %1, off\n\ts_mov_b32 m0, %0":"=&s"(keep):"v"(gsrc),"s"(lds_dst):"memory");}
__device__ __forceinline__ float max3f(float a,float b,float c){float r;asm("v_max3_f32 %0, %1, %2, %3":"=v"(r):"v"(a),"v"(b),"v"(c));return r;}
__device__ __forceinline__ float max2f(float a,float b){float r;asm("v_max_f32_e32 %0, %1, %2":"=v"(r):"v"(a),"v"(b));return r;}
__device__ __forceinline__ float fadd_s(float a,float b){float r;asm("v_add_f32_e32 %0, %1, %2":"=v"(r):"v"(a),"v"(b));return r;}
__device__ __forceinline__ float fsub_s(float a,float b){float r;asm("v_sub_f32_e32 %0, %1, %2":"=v"(r):"v"(a),"v"(b));return r;}
typedef float f32x2_t __attribute__((ext_vector_type(2))); typedef __bf16 bf16x2_t __attribute__((ext_vector_type(2)));
__device__ __forceinline__ unsigned cvtpk_s(float lo,float hi){f32x2_t v={lo,hi};bf16x2_t b=__builtin_convertvector(v,bf16x2_t);return __builtin_bit_cast(unsigned,b);}
#define WAIT_BAR(N) asm volatile("s_waitcnt vmcnt(" #N ") lgkmcnt(0)\n\ts_barrier":::"memory")

__device__ __forceinline__ void qkt(f32x16&p0,f32x16&p1,const char*Kslot,const bf16x8*qr,const f32x16&negm,int r32,int hi){
  const char*kb=Kslot+hi*1024+r32*16;
  #pragma unroll
  for(int d0=0;d0<4;++d0){
    const bf16x8 b0=*reinterpret_cast<const bf16x8*>(kb+d0*2048);
    const bf16x8 b1=*reinterpret_cast<const bf16x8*>(kb+d0*2048+512);
    if(d0==0){p0=__builtin_amdgcn_mfma_f32_32x32x16_bf16(b0,qr[0],negm,0,0,0);p1=__builtin_amdgcn_mfma_f32_32x32x16_bf16(b1,qr[0],negm,0,0,0);}
    else{p0=__builtin_amdgcn_mfma_f32_32x32x16_bf16(b0,qr[d0],p0,0,0,0);p1=__builtin_amdgcn_mfma_f32_32x32x16_bf16(b1,qr[d0],p1,0,0,0);}}
}
typedef __attribute__((address_space(3))) const char* lds_cptr;
typedef short v4i16_t __attribute__((ext_vector_type(4)));
__device__ __forceinline__ void kload8(bf16x8*kf,lds_cptr kp){
  kf[0]=*(const __attribute__((address_space(3))) bf16x8*)(kp);      kf[1]=*(const __attribute__((address_space(3))) bf16x8*)(kp+512);
  kf[2]=*(const __attribute__((address_space(3))) bf16x8*)(kp+2048); kf[3]=*(const __attribute__((address_space(3))) bf16x8*)(kp+2560);
  kf[4]=*(const __attribute__((address_space(3))) bf16x8*)(kp+4096); kf[5]=*(const __attribute__((address_space(3))) bf16x8*)(kp+4608);
  kf[6]=*(const __attribute__((address_space(3))) bf16x8*)(kp+6144); kf[7]=*(const __attribute__((address_space(3))) bf16x8*)(kp+6656);
}
__device__ __forceinline__ void kload2(bf16x8*kf,lds_cptr kp,int j){ kf[2*j]=*(const __attribute__((address_space(3))) bf16x8*)(kp+j*2048); kf[2*j+1]=*(const __attribute__((address_space(3))) bf16x8*)(kp+j*2048+512); }
__device__ __forceinline__ s16x4 vtr(lds_cptr p){ return __builtin_bit_cast(s16x4,__builtin_amdgcn_ds_read_tr16_b64_v4i16((__attribute__((address_space(3))) v4i16_t*)p)); }
__device__ __forceinline__ float rowmax(const f32x16&p0,const f32x16&p1){
  float a=max3f(p0[0],p0[1],p1[0]),b=max3f(p0[2],p0[3],p1[1]);a=max3f(a,p1[2],p1[3]);
  #pragma unroll
  for(int r=4;r<16;r+=4){a=max3f(a,p0[r],p0[r+1]);b=max3f(b,p0[r+2],p0[r+3]);a=max3f(a,p1[r],p1[r+1]);b=max3f(b,p1[r+2],p1[r+3]);}
  const float m=max2f(a,b);
  auto rr=__builtin_amdgcn_permlane32_swap(__float_as_uint(m),__float_as_uint(m),false,false);
  return max2f(__uint_as_float(rr[0]),__uint_as_float(rr[1]));
}
__device__ __forceinline__ void pv(f32x16*o,int vb,bf16x8 pa0,bf16x8 pa1,bf16x8 pa2,bf16x8 pa3){
  #pragma unroll
  for(int d0=0;d0<2;++d0){s16x4 lo[4],hi[4];
    #pragma unroll
    for(int ks=0;ks<4;++ks){
      asm volatile("ds_read_b64_tr_b16 %0,%1 offset:%c2":"=&v"(lo[ks]):"v"(vb),"i"(d0*4096+ks*1024):"memory");
      asm volatile("ds_read_b64_tr_b16 %0,%1 offset:%c2":"=&v"(hi[ks]):"v"(vb),"i"(d0*4096+ks*1024+512):"memory");}
    asm volatile("s_waitcnt lgkmcnt(0)":::"memory");SBAR();
    #define PK(k) (bf16x8){lo[k][0],lo[k][1],lo[k][2],lo[k][3],hi[k][0],hi[k][1],hi[k][2],hi[k][3]}
    o[d0]=__builtin_amdgcn_mfma_f32_32x32x16_bf16(pa0,PK(0),o[d0],0,0,0);
    o[d0]=__builtin_amdgcn_mfma_f32_32x32x16_bf16(pa1,PK(1),o[d0],0,0,0);
    o[d0]=__builtin_amdgcn_mfma_f32_32x32x16_bf16(pa2,PK(2),o[d0],0,0,0);
    o[d0]=__builtin_amdgcn_mfma_f32_32x32x16_bf16(pa3,PK(3),o[d0],0,0,0);
    #undef PK
  }
}

#ifndef ATTN_STORE16
#define ATTN_STORE16(p,v) (*(u32x4*)(p)=(v))
#endif
template<int THRL> __device__ __forceinline__ void attn_unit(int b,int h,int hv,int qb,const bf16*Q,const bf16*__restrict__ K,const bf16*__restrict__ V,bf16*O,char*shm){
  int tid_=threadIdx.x; asm volatile("":"+v"(tid_)); const int tid=tid_,lane=tid&63,r32=lane&31,hi=lane>>5; const int wid=__builtin_amdgcn_readfirstlane(tid>>6);
  const long rowbase=(long)b*SEQ; const int q0=qb*QB;
  const bf16*Qw=Q+(rowbase+q0+wid*QBLK)*DM+h*D;
  const bf16*Kh=K+rowbase*DM+h*D,*Vh=V+rowbase*DM+hv*D;
  const unsigned lds0=(unsigned)(uintptr_t)shm;
  float*wsf=(float*)(shm+LDS_WS)+wid*64;
  const bf16*ksrc=Kh+(long)lane*DM+wid*8;
  const bf16*vsrc=Vh+(long)(16*(wid&3)+(lane>>2))*DM+(wid>>2)*32+(lane&3)*8;
  const unsigned kdst=lds0+LDS_K+wid*1024, vdst=lds0+LDS_V+wid*1024;
  #define DMA_K(t,slot) glds16(ksrc+(long)(t)*KVBLK*DM,(unsigned)__builtin_amdgcn_readfirstlane(kdst+(slot)))
  #define DMA_V(t,slot) glds16(vsrc+(long)(t)*KVBLK*DM,(unsigned)__builtin_amdgcn_readfirstlane(vdst+(slot)))
  const int vb0=(int)(lds0+LDS_V)+((lane>>4)&1)*32+(lane&3)*8+(4*hi+((lane&15)>>2))*64;
  const char*Kbase=shm+LDS_K; bf16x8 kf[8];
  const lds_cptr shm3=(lds_cptr)shm; const lds_cptr kp0=shm3+LDS_K+hi*1024+r32*16; const lds_cptr vp0=shm3+LDS_V+((lane>>4)&1)*32+(lane&3)*8+(4*hi+((lane&15)>>2))*64;
  const int NT=(q0+QB)/KVBLK;
  DMA_K(0,0);DMA_V(0,0);DMA_K(1,SLOTB);
  bf16x8 qr[4];
  #pragma unroll
  for(int d0=0;d0<4;++d0)qr[d0]=*reinterpret_cast<const bf16x8*>(&Qw[(long)r32*DM+d0*16+hi*8]);
  float mhat=0.f,l_reg=0.f;f32x16 o[2];o[0]=f32x16{};o[1]=f32x16{};f32x16 negm=f32x16{};asm volatile("":"+v"(negm));
  const int qrel=wid*QBLK+r32;
  #define CMASK(P0,P1,t) do{int jb_=(t)-(NT-4); if(jb_>=0)cmask(P0,P1,jb_,qrel,hi);}while(0)
  bool resc=false;
  #define START(P0,P1) do{ const float rm=rowmax(P0,P1); resc=false; \
    { const float dl=rm; mhat=fadd_s(mhat,dl); \
      _Pragma("unroll") for(int r=0;r<16;++r){P0[r]=fsub_s(P0[r],dl);P1[r]=fsub_s(P1[r],dl);} \
      _Pragma("unroll") for(int r=0;r<16;++r)negm[r]=-mhat; asm volatile("":"+v"(negm)); } \
    _Pragma("unroll") for(int r=0;r<16;++r)P0[r]=__builtin_amdgcn_exp2f(P0[r]); }while(0)
  #define RESC() do{ if(resc){ asm volatile("s_waitcnt lgkmcnt(0)":::"memory"); \
      _Pragma("unroll") for(int d_=0;d_<2;++d_) _Pragma("unroll") for(int r=0;r<16;++r)o[d_][r]*=wsf[crow(r,hi)]; } }while(0)
  f32x16 pA0,pA1,pB0,pB1;
  int sl_prev=0,sl_cur=0,sl_next=SLOTB;
  #define ROT() do{sl_prev=sl_cur;sl_cur=sl_next;sl_next=(sl_next==(NSLOT-1)*SLOTB)?0:sl_next+SLOTB;}while(0)
  DMA_K(2,2*SLOTB);
  WAIT_BAR(3);
  qkt(pA0,pA1,Kbase,qr,negm,r32,hi);asm volatile("s_nop 15\n\ts_nop 7":"+v"(pA0),"+v"(pA1));CMASK(pA0,pA1,0);
  START(pA0,pA1);
  _Pragma("unroll") for(int r=0;r<16;++r)pA1[r]=__builtin_amdgcn_exp2f(pA1[r]);
  WAIT_BAR(0);
  DMA_K(3,0);DMA_V(1,SLOTB);
  ROT();
  kload8(kf,kp0+sl_cur);
  WAIT_BAR(2);
  s16x4 vlo[8],vhi[8]; u32x4 pw0,pw1,pw2,pw3;
  #define PKW(P,B) cvtpk_s(P[B],P[B+1])
  #define PAF(k) __builtin_bit_cast(bf16x8,pw##k)
  #define VFR(i) (bf16x8){vlo[i][0],vlo[i][1],vlo[i][2],vlo[i][3],vhi[i][0],vhi[i][1],vhi[i][2],vhi[i][3]}
  #define PIN(x) asm volatile("":"+v"(x))
  #define MX3(a,b,c) __builtin_fmaxf(__builtin_fmaxf((a),(b)),(c))
  #define GAPA(MF,A0,A1,A2,A3,W0,W1,PW) do{ MF; sacc+=A0; sacc+=A1; sacc+=A2; sacc+=A3; PIN(sacc); W0; W1; PIN(PW); SBAR(); }while(0)
  #define EX(v) __builtin_amdgcn_exp2f(v)
  #define GAPB(MF,X,B) do{ MF; X[B]=EX(X[B]); X[B+1]=EX(X[B+1]); X[B+2]=EX(X[B+2]); X[B+3]=EX(X[B+3]); PIN(X); SBAR(); }while(0)
  #define VRD(i) do{ vlo[i]=vtr(vp_+(((i)>>2)*4096+((i)&3)*1024)); vhi[i]=vtr(vp_+(((i)>>2)*4096+((i)&3)*1024+512)); }while(0)
  #define KRD(G,j) do{ if(G){ kload2(kf,kp0+sl_next,j); SBAR(); } }while(0)
  #define STEP(C0,C1,P0,P1,t,GK,GV,GL) do{ SBAR(); \
    const lds_cptr vp_=vp0+sl_prev; \
    VRD(0); SBAR(); float sacc=(P0[0]+P0[1]); \
    GAPA(C0=__builtin_amdgcn_mfma_f32_32x32x16_bf16(kf[0],qr[0],negm,0,0,0), P0[2],P0[3],P0[4],P0[5],     pw0[0]=PKW(P0,0), pw0[1]=PKW(P0,2), pw0); \
    VRD(4); SBAR(); GAPA(C1=__builtin_amdgcn_mfma_f32_32x32x16_bf16(kf[1],qr[0],negm,0,0,0), P0[6],P0[7],P0[8],P0[9],     pw0[2]=PKW(P0,4), pw0[3]=PKW(P0,6), pw0); \
    VRD(1); SBAR(); GAPA(C0=__builtin_amdgcn_mfma_f32_32x32x16_bf16(kf[2],qr[1],C0,0,0,0),   P0[10],P0[11],P0[12],P0[13], pw1[0]=PKW(P0,8), pw1[1]=PKW(P0,10), pw1); \
    VRD(5); SBAR(); GAPA(C1=__builtin_amdgcn_mfma_f32_32x32x16_bf16(kf[3],qr[1],C1,0,0,0),   P0[14],P0[15],P1[0],P1[1],   pw1[2]=PKW(P0,12),pw1[3]=PKW(P0,14), pw1); \
    VRD(2); SBAR(); GAPA(C0=__builtin_amdgcn_mfma_f32_32x32x16_bf16(kf[4],qr[2],C0,0,0,0),   P1[2],P1[3],P1[4],P1[5],     pw2[0]=PKW(P1,0), pw2[1]=PKW(P1,2), pw2); \
    VRD(6); SBAR(); GAPA(C1=__builtin_amdgcn_mfma_f32_32x32x16_bf16(kf[5],qr[2],C1,0,0,0),   P1[6],P1[7],P1[8],P1[9],     pw2[2]=PKW(P1,4), pw2[3]=PKW(P1,6), pw2); \
    VRD(3); SBAR(); GAPA(C0=__builtin_amdgcn_mfma_f32_32x32x16_bf16(kf[6],qr[3],C0,0,0,0),   P1[10],P1[11],P1[12],P1[13], pw3[0]=PKW(P1,8), pw3[1]=PKW(P1,10), pw3); \
    VRD(7); SBAR(); GAPA(C1=__builtin_amdgcn_mfma_f32_32x32x16_bf16(kf[7],qr[3],C1,0,0,0),   P1[14],P1[15],0.f,0.f,       pw3[2]=PKW(P1,12),pw3[3]=PKW(P1,14), pw3); \
    l_reg+=sacc; \
    if(GK){DMA_K((t)+3,sl_cur);} if(GV){DMA_V((t)+1,sl_next);} \
    CMASK(C0,C1,t); \
    { float a=MX3(C0[0],C0[1],C1[0]),b=MX3(C0[2],C0[3],C1[1]); a=MX3(a,C1[2],C1[3]); \
      _Pragma("unroll") for(int r=4;r<16;r+=4){a=MX3(a,C0[r],C0[r+1]);b=MX3(b,C0[r+2],C0[r+3]);a=MX3(a,C1[r],C1[r+1]);b=MX3(b,C1[r+2],C1[r+3]);} \
      float rm=__builtin_fmaxf(a,b); { auto rr=__builtin_amdgcn_permlane32_swap(__float_as_uint(rm),__float_as_uint(rm),false,false); rm=__builtin_fmaxf(__uint_as_float(rr[0]),__uint_as_float(rr[1])); } \
      resc=false; \
      if(__builtin_expect(__any(rm>(float)THRL),0)){ const float dl=__builtin_fmaxf(rm,0.f); mhat+=dl; \
        _Pragma("unroll") for(int r=0;r<16;++r){C0[r]-=dl;C1[r]-=dl;} \
        _Pragma("unroll") for(int r=0;r<16;++r)negm[r]=-mhat; asm volatile("":"+v"(negm)); \
        const float f=__builtin_amdgcn_exp2f(-dl); l_reg*=f; if(hi==0)wsf[r32]=f; resc=true; } } \
    SBAR(); \
    GAPB(o[0]=__builtin_amdgcn_mfma_f32_32x32x16_bf16(PAF(0),VFR(0),o[0],0,0,0), C0,0); \
    GAPB(o[1]=__builtin_amdgcn_mfma_f32_32x32x16_bf16(PAF(0),VFR(4),o[1],0,0,0), C0,4); \
    KRD(GL,0); GAPB(o[0]=__builtin_amdgcn_mfma_f32_32x32x16_bf16(PAF(1),VFR(1),o[0],0,0,0), C0,8); \
    KRD(GL,1); GAPB(o[1]=__builtin_amdgcn_mfma_f32_32x32x16_bf16(PAF(1),VFR(5),o[1],0,0,0), C0,12); \
    KRD(GL,2); GAPB(o[0]=__builtin_amdgcn_mfma_f32_32x32x16_bf16(PAF(2),VFR(2),o[0],0,0,0), C1,0); \
    KRD(GL,3); GAPB(o[1]=__builtin_amdgcn_mfma_f32_32x32x16_bf16(PAF(2),VFR(6),o[1],0,0,0), C1,4); \
    GAPB(o[0]=__builtin_amdgcn_mfma_f32_32x32x16_bf16(PAF(3),VFR(3),o[0],0,0,0), C1,8); \
    GAPB(o[1]=__builtin_amdgcn_mfma_f32_32x32x16_bf16(PAF(3),VFR(7),o[1],0,0,0), C1,12); \
    }while(0)
  int t=1;
  #undef CMASK
  #define CMASK(P0,P1,t) do{}while(0)
  for(;t+5<NT;t+=2){
    STEP(pB0,pB1,pA0,pA1,t,true,true,true);     WAIT_BAR(2); RESC(); ROT();
    STEP(pA0,pA1,pB0,pB1,t+1,true,true,true);   WAIT_BAR(2); RESC(); ROT();
  }
  #undef CMASK
  #define CMASK(P0,P1,t) do{int jb_=(t)-(NT-4); if(jb_>=0)cmask(P0,P1,jb_,qrel,hi);}while(0)
  #define ENDW(tt) do{ if((tt)+3<NT){WAIT_BAR(2);} else if((tt)+2<NT){WAIT_BAR(1);} else {WAIT_BAR(0);} }while(0)
  for(;t+1<NT;t+=2){
    STEP(pB0,pB1,pA0,pA1,t,(t+3<NT),(t+1<NT),(t+1<NT));       ENDW(t);   RESC(); ROT();
    STEP(pA0,pA1,pB0,pB1,t+1,(t+4<NT),(t+2<NT),(t+2<NT));     ENDW(t+1); RESC(); ROT();
  }
  STEP(pB0,pB1,pA0,pA1,NT-1,false,false,false); RESC();
  { float sacc=pB0[0]+pB0[1]; _Pragma("unroll") for(int r=2;r<16;++r)sacc+=pB0[r]; _Pragma("unroll") for(int r=0;r<16;++r)sacc+=pB1[r]; l_reg+=sacc;
    pw0=(u32x4){PKW(pB0,0),PKW(pB0,2),PKW(pB0,4),PKW(pB0,6)};pw1=(u32x4){PKW(pB0,8),PKW(pB0,10),PKW(pB0,12),PKW(pB0,14)};pw2=(u32x4){PKW(pB1,0),PKW(pB1,2),PKW(pB1,4),PKW(pB1,6)};pw3=(u32x4){PKW(pB1,8),PKW(pB1,10),PKW(pB1,12),PKW(pB1,14)};
    SBAR(); pv(o,vb0+sl_cur,PAF(0),PAF(1),PAF(2),PAF(3)); }
  #undef PKW
  #undef PAF
  #undef VFR
  #undef PIN
  #undef MX3
  #undef GAPA
  #undef GAPB
  #undef EX
  #undef VRD
  #undef KRD
  #undef STEP
  #undef ENDW
  {auto rr=__builtin_amdgcn_permlane32_swap(__float_as_uint(l_reg),__float_as_uint(l_reg),false,false);l_reg=__uint_as_float(rr[0])+__uint_as_float(rr[1]);}
  if(hi==0)wsf[32+r32]=l_reg;asm volatile("s_waitcnt lgkmcnt(0)":::"memory");
  float rli[16];
  #pragma unroll
  for(int r=0;r<16;++r)rli[r]=__builtin_amdgcn_rcpf(wsf[32+crow(r,hi)]);
  bf16*Ow=O+(rowbase+q0+wid*QBLK)*DM+hv*D;
  { bf16*stg=(bf16*)(shm+LDS_OST)+wid*2048;
    #pragma unroll
    for(int r=0;r<16;++r){const int orow=crow(r,hi);
      #pragma unroll
      for(int d0=0;d0<2;++d0)stg[orow*64+d0*32+r32]=__float2bfloat16(o[d0][r]*rli[r]);}
    asm volatile("s_waitcnt lgkmcnt(0)":::"memory");
    #pragma unroll
    for(int i=0;i<4;++i){const int row=i*8+(lane>>3),ch=lane&7; const u32x4 v=*(const u32x4*)(stg+row*64+ch*8); ATTN_STORE16(Ow+(long)row*DM+ch*8,v);} }
  asm volatile("s_waitcnt lgkmcnt(0)\n\ts_barrier":::"memory");
  #undef DMA_K
  #undef DMA_V
  #undef CMASK
  #undef START
  #undef RESC
  #undef ROT
}
constexpr int ATTN_LDS_BYTES=LDS_BYTES;
struct AttnTensors { const bf16* Q; const bf16* K; const bf16* V; bf16* O1; bf16* O2; };
struct AttnUnit { int combo; int qb; };
struct StaticOrder {
  int vcu,G,blk;
  __device__ __forceinline__ explicit StaticOrder(int grid,int block):vcu((grid%8==0)?(block%8)*(grid/8)+block/8:block),G(grid),blk(block){}
  __device__ __forceinline__ bool next(int i,AttnUnit&u)const{
    if(G==256){ if(i>=32)return false; const int s=vcu&7,j=i&3; u.combo=(i>>2)*32+(vcu>>3); u.qb=(j==0)?s:(j==1)?15-s:(j==2)?16+s:31-s; return true; }
    const long L=(long)i*G+blk; if(L>=8192)return false; u.combo=(int)(L>>5); u.qb=31-(int)(L&31); return true; }
};
template<class Sched,int THRL=8> __device__ __forceinline__ void attn_phase(char*lds,const AttnTensors&T,const Sched&S){
  AttnUnit u;
  for(int i=0;S.next(i,u);++i){ const int b=u.combo>>5,hq=(u.combo>>1)&15,vh=u.combo&1; const int hv=(hq>>1)*2+vh;
    attn_unit<THRL>(b,hq,hv,u.qb,T.Q,T.K,T.V,(hq&1)?T.O2:T.O1,lds); }
}
#undef SBAR
#undef WAIT_BAR
}

#include <hip/hip_cooperative_groups.h>
namespace cg = cooperative_groups;

constexpr int NWAVES = 8;
#ifndef STOP_AFTER
#define STOP_AFTER 99
#endif
constexpr int DM = 1024, FF = 4096, NP = 65536, NS = 256, M = NP + NS;
constexpr float EPS = 1e-6f;
constexpr float LAM_INIT = 0.35550906759f;
constexpr size_t O_Y = 0, O_KP = (size_t)M * DM, O_VP = O_KP + (size_t)NP * DM, O_STP = O_VP + (size_t)NP * DM, O_KS = O_STP + (size_t)8 * 8 * 128 * 128,
                 O_VS = O_KS + (size_t)NS * DM, O_STS = O_VS + (size_t)NS * DM, O_END = O_STS + (size_t)16 * 8 * 128 * 128;
constexpr size_t MiB = 1u << 20;
constexpr size_t WS_OML = 1 * MiB;
constexpr size_t WS_WIN = 2 * MiB, WS_WHO = 10 * MiB, WS_WUP0 = 12 * MiB, WS_WDN0 = 20 * MiB, WS_WQKV = 28 * MiB, WS_WDO = 34 * MiB, WS_WUP1 = 36 * MiB, WS_WDN1 = 44 * MiB;
constexpr size_t WS_XN = 64 * MiB;
constexpr size_t WS_MB = 196 * MiB;
constexpr size_t WS_R0 = 328 * MiB;
constexpr size_t WS_Q = WS_R0, WS_K = WS_R0 + 130 * MiB, WS_V = WS_R0 + 260 * MiB, WS_O1 = WS_R0 + 390 * MiB;
constexpr size_t WS_O2 = WS_R0 + 520 * MiB;
constexpr size_t WS_PACC = WS_O2 + 130 * MiB;
constexpr size_t WS_END = WS_PACC + 4 * MiB;
constexpr int SPLK = 4;
constexpr size_t WS_RS = 1 * MiB + 65536;
static_assert(WS_O2 + (size_t)M * DM * 2 <= WS_END && WS_END <= 1024 * MiB && WS_O1 + (size_t)M * DM * 2 <= WS_O2 && WS_R0 + (size_t)M * FF * 2 <= WS_END && WS_XN + (size_t)M * DM * 2 <= WS_MB && WS_MB + (size_t)M * DM * 2 <= WS_R0, "d_ws map");

constexpr int RING_OFF = 0, RING_BYTES = 131072;
constexpr int LDS_BYTES = 155648;

#define GAS __attribute__((address_space(1)))
#define LAS __attribute__((address_space(3)))
typedef unsigned short bf16;
typedef unsigned v4u __attribute__((ext_vector_type(4)));
typedef unsigned v2u __attribute__((ext_vector_type(2)));
typedef float f32x4 __attribute__((ext_vector_type(4)));
typedef short bf16x8 __attribute__((ext_vector_type(8)));
#define LDS_WAIT() asm volatile("s_waitcnt lgkmcnt(0)" ::: "memory")
__device__ __forceinline__ unsigned pk2(float lo, float hi) { return pg8::cvt_pk_bf16(lo, hi); }
__device__ __forceinline__ float bf2f(unsigned short u) { return __uint_as_float((unsigned)u << 16); }
__device__ __forceinline__ float bflo(unsigned u) { return __uint_as_float(u << 16); }
__device__ __forceinline__ float bfhi(unsigned u) { return __uint_as_float(u & 0xffff0000u); }
template <int CTRL> __device__ __forceinline__ float dpp_f(float v) { return __builtin_bit_cast(float, __builtin_amdgcn_update_dpp(0, __builtin_bit_cast(int, v), CTRL, 0xf, 0xf, true)); }
__device__ __forceinline__ float wave_sum(float v) {
#pragma unroll
    for (int o = 1; o < 64; o <<= 1) v += __shfl_xor(v, o);
    return v;
}
__device__ __forceinline__ float wave_max(float v) {
#pragma unroll
    for (int o = 1; o < 64; o <<= 1) v = fmaxf(v, __shfl_xor(v, o));
    return v;
}

struct Frame {
    LAS unsigned char* lds;
    int tid, lane, wave, vcu, G;
};

__device__ __forceinline__ void p0_transpose_item(const float* W, const float* gain, int K, int N, bf16* WT, int row_off, LAS float* scr, int item, int lane) {
    const int nblk = N / 32, kb = item / nblk, nb = item % nblk, k0 = 64 * kb, n0 = 32 * nb;
    if (gain) {
        float wv[32], gv[32];
#pragma unroll
        for (int i = 0; i < 32; ++i) { const int kk = 2 * i + (lane >> 5); wv[i] = W[(size_t)(k0 + kk) * N + n0 + (lane & 31)]; gv[i] = gain[k0 + kk]; }
#pragma unroll
        for (int i = 0; i < 32; ++i) { const int kk = 2 * i + (lane >> 5); scr[kk * 33 + (lane & 31)] = gv[i] * wv[i]; }
    } else {
        float wv[32];
#pragma unroll
        for (int i = 0; i < 32; ++i) { const int kk = 2 * i + (lane >> 5); wv[i] = W[(size_t)(k0 + kk) * N + n0 + (lane & 31)]; }
#pragma unroll
        for (int i = 0; i < 32; ++i) { const int kk = 2 * i + (lane >> 5); scr[kk * 33 + (lane & 31)] = wv[i]; }
    }
    LDS_WAIT(); asm volatile("" ::: "memory");
    const int c = lane & 7;
#pragma unroll
    for (int j = 0; j < 4; ++j) { const int n = (lane >> 3) + 8 * j; const LAS float* s = scr + (8 * c) * 33 + n;
        v4u o; o.x = pk2(s[0 * 33], s[1 * 33]); o.y = pk2(s[2 * 33], s[3 * 33]); o.z = pk2(s[4 * 33], s[5 * 33]); o.w = pk2(s[6 * 33], s[7 * 33]);
        *(v4u*)(WT + (size_t)(row_off + n0 + n) * K + k0 + 8 * c) = o; }
    LDS_WAIT(); asm volatile("" ::: "memory");
}

struct Args {
    const float* in[18]; float* out; unsigned char* ws;
};

__device__ __forceinline__ void rms_row_to_bf16(const float* xrow, bf16* orow, float* rs, int lane) {
    const f32x4* xr = (const f32x4*)xrow;
    f32x4 v[4]; v[0] = xr[2 * lane]; v[1] = xr[2 * lane + 1]; v[2] = xr[128 + 2 * lane]; v[3] = xr[128 + 2 * lane + 1];
    float s = 0.f;
#pragma unroll
    for (int j = 0; j < 4; ++j) s += (v[j].x * v[j].x + v[j].y * v[j].y) + (v[j].z * v[j].z + v[j].w * v[j].w);
    const float ms = wave_sum(s) * (1.f / DM) + EPS; const float r = rsqrtf(ms);
    if (lane == 0) *rs = sqrtf(ms);
    v4u o0, o1;
    o0.x = pk2(v[0].x * r, v[0].y * r); o0.y = pk2(v[0].z * r, v[0].w * r); o0.z = pk2(v[1].x * r, v[1].y * r); o0.w = pk2(v[1].z * r, v[1].w * r);
    o1.x = pk2(v[2].x * r, v[2].y * r); o1.y = pk2(v[2].z * r, v[2].w * r); o1.z = pk2(v[3].x * r, v[3].y * r); o1.w = pk2(v[3].z * r, v[3].w * r);
    *(v4u*)(orow + 8 * lane) = o0; *(v4u*)(orow + 512 + 8 * lane) = o1;
}

template <bool LAST>
__device__ __forceinline__ void norm_phase(const Frame& F, const bf16* MB, const float* pacc, const float* gpost, float* RS, float* out, bf16* XN) {
    const int gw = F.vcu * NWAVES + F.wave, NGW = F.G * NWAVES, lane = F.lane;
    f32x4 g[4]; { const f32x4* gp = (const f32x4*)gpost; g[0] = gp[2 * lane]; g[1] = gp[2 * lane + 1]; g[2] = gp[128 + 2 * lane]; g[3] = gp[128 + 2 * lane + 1]; }
    v4u nm0 = {}, nm1 = {}, nx0 = {}, nx1 = {}; float nhs = 0.f;
#define NP_LOAD(r_) do { nm0 = *(const v4u*)(MB + (size_t)(r_) * DM + 8 * lane); nm1 = *(const v4u*)(MB + (size_t)(r_) * DM + 512 + 8 * lane); \
        nx0 = *(const v4u*)(XN + (size_t)(r_) * DM + 8 * lane); nx1 = *(const v4u*)(XN + (size_t)(r_) * DM + 512 + 8 * lane); nhs = RS[r_]; } while (0)
    if (gw < M) NP_LOAD(gw);
    for (int row = gw; row < M; row += NGW) {
        const v4u m0 = nm0, m1 = nm1, x0 = nx0, x1 = nx1; const float hs = nhs;
        if (row + NGW < M) NP_LOAD(row + NGW);
        f32x4 v[4], mm[4];
        v[0] = (f32x4){bflo(x0.x), bfhi(x0.x), bflo(x0.y), bfhi(x0.y)}; v[1] = (f32x4){bflo(x0.z), bfhi(x0.z), bflo(x0.w), bfhi(x0.w)};
        v[2] = (f32x4){bflo(x1.x), bfhi(x1.x), bflo(x1.y), bfhi(x1.y)}; v[3] = (f32x4){bflo(x1.z), bfhi(x1.z), bflo(x1.w), bfhi(x1.w)};
        mm[0] = (f32x4){bflo(m0.x), bfhi(m0.x), bflo(m0.y), bfhi(m0.y)}; mm[1] = (f32x4){bflo(m0.z), bfhi(m0.z), bflo(m0.w), bfhi(m0.w)};
        mm[2] = (f32x4){bflo(m1.x), bfhi(m1.x), bflo(m1.y), bfhi(m1.y)}; mm[3] = (f32x4){bflo(m1.z), bfhi(m1.z), bflo(m1.w), bfhi(m1.w)};
        if (row >= NP) {
            const f32x4* pp = (const f32x4*)(pacc + (size_t)(row - NP) * DM);
            mm[0] = pp[2 * lane]; mm[1] = pp[2 * lane + 1]; mm[2] = pp[128 + 2 * lane]; mm[3] = pp[128 + 2 * lane + 1];
#pragma unroll
            for (int p = 1; p < SPLK; ++p) { const f32x4* pq_ = pp + (size_t)p * (NS * DM / 4); mm[0] += pq_[2 * lane]; mm[1] += pq_[2 * lane + 1]; mm[2] += pq_[128 + 2 * lane]; mm[3] += pq_[128 + 2 * lane + 1]; }
        }
        float s = 0.f;
#pragma unroll
        for (int j = 0; j < 4; ++j) s += (mm[j].x * mm[j].x + mm[j].y * mm[j].y) + (mm[j].z * mm[j].z + mm[j].w * mm[j].w);
        const float r = rsqrtf(wave_sum(s) * (1.f / DM) + EPS);
        float s2 = 0.f;
#pragma unroll
        for (int j = 0; j < 4; ++j) { v[j] = v[j] * hs + mm[j] * r * g[j]; s2 += (v[j].x * v[j].x + v[j].y * v[j].y) + (v[j].z * v[j].z + v[j].w * v[j].w); }
        if (LAST) {
            f32x4* dr = (f32x4*)(out + (size_t)row * DM);
            dr[2 * lane] = v[0]; dr[2 * lane + 1] = v[1]; dr[128 + 2 * lane] = v[2]; dr[128 + 2 * lane + 1] = v[3];
        } else {
            const float ms = wave_sum(s2) * (1.f / DM) + EPS; const float r2 = rsqrtf(ms);
            if (lane == 0) RS[row] = sqrtf(ms);
            v4u o0, o1;
            o0.x = pk2(v[0].x * r2, v[0].y * r2); o0.y = pk2(v[0].z * r2, v[0].w * r2); o0.z = pk2(v[1].x * r2, v[1].y * r2); o0.w = pk2(v[1].z * r2, v[1].w * r2);
            o1.x = pk2(v[2].x * r2, v[2].y * r2); o1.y = pk2(v[2].z * r2, v[2].w * r2); o1.z = pk2(v[3].x * r2, v[3].y * r2); o1.w = pk2(v[3].z * r2, v[3].w * r2);
            *(v4u*)(XN + (size_t)row * DM + 8 * lane) = o0; *(v4u*)(XN + (size_t)row * DM + 512 + 8 * lane) = o1;
        }
    }
#undef NP_LOAD
}

__device__ __forceinline__ float compute_lam(const float* lp, int lane) {
    const float a = wave_sum(lp[lane] * lp[64 + lane]), b = wave_sum(lp[128 + lane] * lp[192 + lane]);
    return __expf(a) - __expf(b) + LAM_INIT;
}

__device__ __forceinline__ void combine_phase(const Frame& F, const bf16* O1, const bf16* O2, const float* lp, const float* subg, bf16* OC) {
    const int gw = F.vcu * NWAVES + F.wave, NGW = F.G * NWAVES, lane = F.lane;
    const float lam = compute_lam(lp, lane);
    float sg[16];
#pragma unroll
    for (int e = 0; e < 16; ++e) sg[e] = subg[16 * (lane & 7) + e] * (1.0f - LAM_INIT);
    v4u na0 = {}, na1 = {}, nb0 = {}, nb1 = {};
#define CP_LOAD(r_) do { const size_t o_ = (size_t)(r_) * DM + 16 * lane; na0 = *(const v4u*)(O1 + o_); na1 = *(const v4u*)(O1 + o_ + 8); nb0 = *(const v4u*)(O2 + o_); nb1 = *(const v4u*)(O2 + o_ + 8); } while (0)
    if (gw < NP) CP_LOAD(gw);
    for (int row = gw; row < NP; row += NGW) {
        const size_t off = (size_t)row * DM + 16 * lane;
        const v4u a0 = na0, a1 = na1, b0 = nb0, b1 = nb1;
        if (row + NGW < NP) CP_LOAD(row + NGW);
        float o[16];
        const unsigned aw[8] = {a0.x, a0.y, a0.z, a0.w, a1.x, a1.y, a1.z, a1.w}, bw[8] = {b0.x, b0.y, b0.z, b0.w, b1.x, b1.y, b1.z, b1.w};
        float s = 0.f;
#pragma unroll
        for (int e = 0; e < 8; ++e) { o[2 * e] = bflo(aw[e]) - lam * bflo(bw[e]); o[2 * e + 1] = bfhi(aw[e]) - lam * bfhi(bw[e]); s += o[2 * e] * o[2 * e] + o[2 * e + 1] * o[2 * e + 1]; }
        s += __shfl_xor(s, 1); s += __shfl_xor(s, 2); s += __shfl_xor(s, 4);
        const float r = rsqrtf(s * (1.f / 128.f) + EPS);
        v4u w0, w1;
        w0.x = pk2(o[0] * r * sg[0], o[1] * r * sg[1]); w0.y = pk2(o[2] * r * sg[2], o[3] * r * sg[3]); w0.z = pk2(o[4] * r * sg[4], o[5] * r * sg[5]); w0.w = pk2(o[6] * r * sg[6], o[7] * r * sg[7]);
        w1.x = pk2(o[8] * r * sg[8], o[9] * r * sg[9]); w1.y = pk2(o[10] * r * sg[10], o[11] * r * sg[11]); w1.z = pk2(o[12] * r * sg[12], o[13] * r * sg[13]); w1.w = pk2(o[14] * r * sg[14], o[15] * r * sg[15]);
        *(v4u*)(OC + off) = w0; *(v4u*)(OC + off + 8) = w1;
    }
#undef CP_LOAD
}

namespace hg {
#define HGT 0
constexpr int QT_P = 136, KH_P = 72, ST_P = 136;
constexpr int L_QT = 0, L_KT = 17408, L_KHT = 34816, L_VT = 53248, L_AM = 71680, L_ST = 80896, L_BSUM = 115712, L_DL = 117760, L_SSQ = 118272, L_OST = 118784, OST_P = 72, L_RV = L_OST + 8 * 16 * OST_P * 2, L_END = L_RV + 64 * QT_P * 2;
static_assert(L_END <= LDS_BYTES, "hgrn LDS");
#define HG_MFMA(a, b, c) __builtin_amdgcn_mfma_f32_16x16x32_bf16((a), (b), (c), 0, 0, 0)
template <int ntok>
__device__ __forceinline__ void hgrn_item(LAS unsigned char* lds, const bf16* HG, bf16* OUT, const float* S0, float* Sout, long row0, int nchunk, int h, const float* onorm_g) {
    int tid_ = threadIdx.x; asm volatile("" : "+v"(tid_));
    const int tid = tid_, lane = tid & 63, wid = __builtin_amdgcn_readfirstlane(tid >> 6);
    const int kc = tid & 127, qt = wid >> 1, fr = lane & 15, fq = lane >> 4;
    LAS bf16* Qt = (LAS bf16*)(lds + L_QT); LAS bf16* Kt = (LAS bf16*)(lds + L_KT); LAS bf16* KhT = (LAS bf16*)(lds + L_KHT); LAS bf16* VT = (LAS bf16*)(lds + L_VT);
    LAS bf16* Am = (LAS bf16*)(lds + L_AM); LAS bf16* ST = (LAS bf16*)(lds + L_ST);
    LAS bf16* ost = (LAS bf16*)(lds + L_OST) + wid * (16 * OST_P);
    LAS float* bsum = (LAS float*)(lds + L_BSUM); LAS float* dlast = (LAS float*)(lds + L_DL); LAS float* ssq = (LAS float*)(lds + L_SSQ);
    const int ti = wid >> 1, vh = wid & 1;
    f32x4 sacc[8];
#pragma unroll
    for (int vt = 0; vt < 8; ++vt) {
#pragma unroll
        for (int i = 0; i < 4; ++i) sacc[vt][i] = S0 ? S0[(size_t)(16 * wid + 4 * fq + i) * 128 + 16 * vt + fr] : 0.f;
    }
    __syncthreads();
#pragma unroll
    for (int vt = 0; vt < 8; ++vt) { v2u w; w.x = pk2(sacc[vt][0], sacc[vt][1]); w.y = pk2(sacc[vt][2], sacc[vt][3]); *(LAS v2u*)(ST + (16 * vt + fr) * ST_P + 16 * wid + 4 * fq) = w; }
    float og[4];
#pragma unroll
    for (int j = 0; j < 4; ++j) og[j] = onorm_g[h * 128 + 16 * (4 * vh + j) + fr];
    LAS bf16* RV = (LAS bf16*)(lds + L_RV);
    v4u pq[2], pk[2], pv[2], pg[2];
#define HG_LOAD(c) do { _Pragma("unroll") for (int e = 0; e < 2; ++e) { const int id = tid + 512 * e, r_ = id >> 4, pc = id & 15; const int rc = (ntok >= 64 || r_ < ntok) ? r_ : ntok - 1; \
            const bf16* p = HG + (size_t)(row0 + (long)(c) * 64 + rc) * 4096 + h * 128 + pc * 8; pq[e] = *(const v4u*)p; pk[e] = *(const v4u*)(p + 1024); pv[e] = *(const v4u*)(p + 2048); } \
        _Pragma("unroll") for (int hh = 0; hh < 2; ++hh) { const int r_ = 16 * ti + (lane >> 2); const int rc = (ntok >= 64 || r_ < ntok) ? r_ : ntok - 1; \
            pg[hh] = *(const v4u*)(HG + (size_t)(row0 + (long)(c) * 64 + rc) * 4096 + 3072 + h * 128 + 64 * vh + 8 * ((lane & 3) + 4 * hh)); } } while (0)
    HG_LOAD(0);
    for (int c = 0; c < nchunk; ++c) {
        float q[16], k[16]; unsigned vpk[8]; v4u gcur[2];
#pragma unroll
        for (int e = 0; e < 2; ++e) { const int id = tid + 512 * e, r_ = id >> 4, pc = id & 15;
            *(LAS v4u*)(Qt + r_ * QT_P + pc * 8) = pq[e]; *(LAS v4u*)(Kt + r_ * QT_P + pc * 8) = pk[e]; *(LAS v4u*)(RV + r_ * QT_P + pc * 8) = pv[e]; }
        gcur[0] = pg[0]; gcur[1] = pg[1];
        if (c + 1 < nchunk) HG_LOAD(c + 1);
        __syncthreads();
        { unsigned short rv[16];
#pragma unroll
          for (int i = 0; i < 16; ++i) { const bool ok = (ntok >= 64) || (16 * qt + i) < ntok; const int o_ = (16 * qt + i) * QT_P + kc;
              const unsigned short tq_ = Qt[o_], tk_ = Kt[o_], tv_ = RV[o_]; q[i] = ok ? bf2f(tq_) : 0.f; k[i] = ok ? bf2f(tk_) : 0.f; rv[i] = ok ? tv_ : (unsigned short)0; }
#pragma unroll
          for (int i = 0; i < 8; ++i) vpk[i] = (unsigned)rv[2 * i] | ((unsigned)rv[2 * i + 1] << 16); }
        float g[16]; float run = 1.f;
#pragma unroll
        for (int i = 0; i < 16; ++i) { run *= (1.0f - k[i]); g[i] = run; }
        bsum[qt * 128 + kc] = run;
        __syncthreads();
        float off = 1.f, tot = 1.f;
#pragma unroll
        for (int j = 0; j < 4; ++j) { const float s_ = bsum[j * 128 + kc]; tot *= s_; off *= (j < qt) ? s_ : 1.f; }
        unsigned khp[8];
#pragma unroll
        for (int i = 0; i < 16; i += 2) {
            const float p0 = off * g[i], p1 = off * g[i + 1]; const float r0 = __builtin_amdgcn_rcpf(p0), r1 = __builtin_amdgcn_rcpf(p1);
            const unsigned qq = pk2(q[i] * p0, q[i + 1] * p1), kk = pk2(k[i] * r0, k[i + 1] * r1);
            Qt[(16 * qt + i) * QT_P + kc] = (bf16)(qq & 0xffffu); Qt[(16 * qt + i + 1) * QT_P + kc] = (bf16)(qq >> 16);
            Kt[(16 * qt + i) * QT_P + kc] = (bf16)(kk & 0xffffu); Kt[(16 * qt + i + 1) * QT_P + kc] = (bf16)(kk >> 16);
            khp[i >> 1] = pk2(k[i] * (tot * r0), k[i + 1] * (tot * r1));
        }
        *(LAS v4u*)(KhT + kc * KH_P + 16 * qt) = (v4u){khp[0], khp[1], khp[2], khp[3]}; *(LAS v4u*)(KhT + kc * KH_P + 16 * qt + 8) = (v4u){khp[4], khp[5], khp[6], khp[7]};
        *(LAS v4u*)(VT + kc * KH_P + 16 * qt) = (v4u){vpk[0], vpk[1], vpk[2], vpk[3]}; *(LAS v4u*)(VT + kc * KH_P + 16 * qt + 8) = (v4u){vpk[4], vpk[5], vpk[6], vpk[7]};
        if (qt == 0) dlast[kc] = tot;
        __syncthreads();
        { bf16x8 af[4];
#pragma unroll
          for (int kk = 0; kk < 4; ++kk) af[kk] = *(const LAS bf16x8*)(Qt + (16 * ti + fr) * QT_P + 32 * kk + 8 * fq);
#pragma unroll
          for (int jj = 0; jj < 2; ++jj) { const int sj = 2 * vh + jj;
            f32x4 a = (f32x4){0.f, 0.f, 0.f, 0.f};
            if (sj <= ti) { bf16x8 bfr[4];
#pragma unroll
                for (int kk = 0; kk < 4; ++kk) bfr[kk] = *(const LAS bf16x8*)(Kt + (16 * sj + fr) * QT_P + 32 * kk + 8 * fq);
                __builtin_amdgcn_sched_barrier(0);
#pragma unroll
                for (int kk = 0; kk < 4; ++kk) a = HG_MFMA(af[kk], bfr[kk], a);
            }
#pragma unroll
            for (int i = 0; i < 4; ++i) { const int t = 16 * ti + 4 * fq + i, s_ = 16 * sj + fr; const float val = (s_ <= t) ? a[i] : 0.f; Am[t * KH_P + s_] = (bf16)(pk2(val, 0.f) & 0xffffu); }
          } }
        __syncthreads();
        f32x4 oacc[4];
        { bf16x8 aA[2], aQ[4], bb[2][6];
#pragma unroll
          for (int kk = 0; kk < 2; ++kk) aA[kk] = *(const LAS bf16x8*)(Am + (16 * ti + fr) * KH_P + 32 * kk + 8 * fq);
#pragma unroll
          for (int kk = 0; kk < 4; ++kk) aQ[kk] = *(const LAS bf16x8*)(Qt + (16 * ti + fr) * QT_P + 32 * kk + 8 * fq);
#define HG_LDB(dst, vt_) do { _Pragma("unroll") for (int kk = 0; kk < 2; ++kk) dst[kk] = *(const LAS bf16x8*)(VT + (16 * (vt_) + fr) * KH_P + 32 * kk + 8 * fq); \
              _Pragma("unroll") for (int kk = 0; kk < 4; ++kk) dst[2 + kk] = *(const LAS bf16x8*)(ST + (16 * (vt_) + fr) * ST_P + 32 * kk + 8 * fq); } while (0)
          HG_LDB(bb[0], 4 * vh);
#pragma unroll
          for (int j = 0; j < 4; ++j) { f32x4 o = (f32x4){0.f, 0.f, 0.f, 0.f};
              if (j + 1 < 4) HG_LDB(bb[(j + 1) & 1], 4 * vh + j + 1);
              __builtin_amdgcn_sched_barrier(0);
#pragma unroll
              for (int kk = 0; kk < 2; ++kk) o = HG_MFMA(aA[kk], bb[j & 1][kk], o);
#pragma unroll
              for (int kk = 0; kk < 4; ++kk) o = HG_MFMA(aQ[kk], bb[j & 1][2 + kk], o);
              oacc[j] = o; }
#undef HG_LDB
        }
#pragma unroll
        for (int i = 0; i < 4; ++i) { float p = 0.f;
#pragma unroll
            for (int j = 0; j < 4; ++j) p += oacc[j][i] * oacc[j][i];
            p += dpp_f<0xB1>(p); p += dpp_f<0x4E>(p); p += dpp_f<0x124>(p); p += dpp_f<0x128>(p);
            if (fr == 0) ssq[vh * 64 + 16 * ti + 4 * fq + i] = p; }
        __syncthreads();
#pragma unroll
        for (int i = 0; i < 4; ++i) { const int t = 16 * ti + 4 * fq + i; const float r = rsqrtf((ssq[t] + ssq[64 + t]) * (1.f / 128.f) + EPS);
#pragma unroll
            for (int j = 0; j < 4; ++j) ost[(4 * fq + i) * OST_P + 16 * j + fr] = (bf16)(pk2(oacc[j][i] * r * og[j], 0.f) & 0xffffu); }
        asm volatile("s_waitcnt lgkmcnt(0)" ::: "memory");
#pragma unroll
        for (int hh = 0; hh < 2; ++hh) { const int orow = lane >> 2, och = (lane & 3) + 4 * hh; const v4u w = *(const LAS v4u*)(ost + orow * OST_P + 8 * och); const v4u gg = gcur[hh];
            v4u o4; o4.x = pk2(bflo(w.x) * bflo(gg.x), bfhi(w.x) * bfhi(gg.x)); o4.y = pk2(bflo(w.y) * bflo(gg.y), bfhi(w.y) * bfhi(gg.y));
            o4.z = pk2(bflo(w.z) * bflo(gg.z), bfhi(w.z) * bfhi(gg.z)); o4.w = pk2(bflo(w.w) * bflo(gg.w), bfhi(w.w) * bfhi(gg.w));
            if (ntok >= 64 || 16 * ti + orow < ntok) *(v4u*)(OUT + (size_t)(row0 + (long)c * 64 + 16 * ti + orow) * DM + h * 128 + 64 * vh + 8 * och) = o4; }
        asm volatile("s_waitcnt lgkmcnt(0)" ::: "memory");
        { float d[4];
#pragma unroll
          for (int i = 0; i < 4; ++i) d[i] = dlast[16 * wid + 4 * fq + i];
          bf16x8 aK[2];
#pragma unroll
          for (int kk = 0; kk < 2; ++kk) aK[kk] = *(const LAS bf16x8*)(KhT + (16 * wid + fr) * KH_P + 32 * kk + 8 * fq);
#pragma unroll
          for (int g4 = 0; g4 < 2; ++g4) { bf16x8 bv[4][2];
#pragma unroll
              for (int u = 0; u < 4; ++u)
#pragma unroll
                  for (int kk = 0; kk < 2; ++kk) bv[u][kk] = *(const LAS bf16x8*)(VT + (16 * (4 * g4 + u) + fr) * KH_P + 32 * kk + 8 * fq);
              __builtin_amdgcn_sched_barrier(0);
#pragma unroll
              for (int u = 0; u < 4; ++u) { const int vt = 4 * g4 + u; f32x4 a = sacc[vt];
#pragma unroll
                  for (int i = 0; i < 4; ++i) a[i] *= d[i];
#pragma unroll
                  for (int kk = 0; kk < 2; ++kk) a = HG_MFMA(aK[kk], bv[u][kk], a);
                  sacc[vt] = a;
                  v2u w; w.x = pk2(a[0], a[1]); w.y = pk2(a[2], a[3]); *(LAS v2u*)(ST + (16 * vt + fr) * ST_P + 16 * wid + 4 * fq) = w; } } }
    }
#undef HG_LOAD
#pragma unroll
    for (int vt = 0; vt < 8; ++vt) {
#pragma unroll
        for (int i = 0; i < 4; ++i) Sout[(size_t)(16 * wid + 4 * fq + i) * 128 + 16 * vt + fr] = sacc[vt][i];
    }
    __syncthreads();
}
}

namespace sa {
constexpr int SCP = 1044, NQ = 8;
constexpr int L_Q = 0, L_SC = 8192, L_OACC = L_SC + NQ * SCP * 4, L_O0 = L_OACC + 4 * NQ * 128 * 4, L_END = L_O0 + NQ * 128 * 4;
static_assert(L_END <= RING_BYTES, "sample attention LDS");
__device__ __forceinline__ void item(LAS unsigned char* lds, int it2, const bf16* Qb, const bf16* Kb, const bf16* Vb, const float* ck, const float* cv, bf16* OC, float lam, const float* subg) {
    int tid_ = threadIdx.x; asm volatile("" : "+v"(tid_));
    const int tid = tid_, lane = tid & 63, wid = __builtin_amdgcn_readfirstlane(tid >> 6);
    const int it = it2 >> 1, q0 = (it2 & 1) * NQ, b = it >> 3, h = it & 7;
    LAS float* Qs = (LAS float*)(lds + L_Q); LAS float* SC = (LAS float*)(lds + L_SC); LAS float* OA = (LAS float*)(lds + L_OACC); LAS float* O0 = (LAS float*)(lds + L_O0);
    const size_t srow = (size_t)NP + (size_t)b * 16;
    __syncthreads();
    if (tid < 256) { const int idx = tid * 4, c = idx >> 9, qq = (idx >> 6) & 7, d = idx & 63;
      const v2u w = *(const v2u*)(Qb + (srow + q0 + qq) * DM + h * 128 + c * 64 + d);
      Qs[idx] = bflo(w.x); Qs[idx + 1] = bfhi(w.x); Qs[idx + 2] = bflo(w.y); Qs[idx + 3] = bfhi(w.y); }
    __syncthreads();
    for (int c = 0; c < 2; ++c) {
        for (int key = tid; key < 1040; key += 512) {
            float s[NQ];
            float kd[64];
            if (key < 1024) { const f32x4* kp = (const f32x4*)(ck + (((size_t)b * 1024 + key) * 8 + h) * 128 + c * 64);
#pragma unroll
                for (int j = 0; j < 16; ++j) { const f32x4 t4 = kp[j]; kd[4 * j] = t4.x; kd[4 * j + 1] = t4.y; kd[4 * j + 2] = t4.z; kd[4 * j + 3] = t4.w; } }
            else { const v4u* kp = (const v4u*)(Kb + (srow + (key - 1024)) * DM + h * 128 + c * 64);
#pragma unroll
                for (int j = 0; j < 8; ++j) { const v4u t4 = kp[j]; kd[8 * j] = bflo(t4.x); kd[8 * j + 1] = bfhi(t4.x); kd[8 * j + 2] = bflo(t4.y); kd[8 * j + 3] = bfhi(t4.y);
                    kd[8 * j + 4] = bflo(t4.z); kd[8 * j + 5] = bfhi(t4.z); kd[8 * j + 6] = bflo(t4.w); kd[8 * j + 7] = bfhi(t4.w); } }
#pragma unroll
            for (int qq = 0; qq < NQ; ++qq) { const LAS f32x4* qp = (const LAS f32x4*)(Qs + c * (NQ * 64) + qq * 64); float a = 0.f;
#pragma unroll
                for (int j = 0; j < 16; ++j) { const f32x4 q4 = qp[j]; a += (kd[4 * j] * q4.x + kd[4 * j + 1] * q4.y) + (kd[4 * j + 2] * q4.z + kd[4 * j + 3] * q4.w); }
                s[qq] = a; }
#pragma unroll
            for (int qq = 0; qq < NQ; ++qq) SC[qq * SCP + key] = s[qq];
        }
        __syncthreads();
        { LAS float* row = SC + wid * SCP;
            float mx = -INFINITY; for (int key = lane; key < 1040; key += 64) mx = fmaxf(mx, row[key]);
            mx = wave_max(mx);
            float sm = 0.f; for (int key = lane; key < 1040; key += 64) { const float p = exp2f(row[key] - mx); row[key] = p; sm += p; }
            sm = wave_sum(sm); const float inv = 1.0f / sm;
            for (int key = lane; key < 1040; key += 64) row[key] *= inv; }
        __syncthreads();
        { const int e = tid & 127, kq = wid >> 1; float acc[NQ];
#pragma unroll
          for (int qq = 0; qq < NQ; ++qq) acc[qq] = 0.f;
          for (int key = kq * 256; key < kq * 256 + 256; key += 16) {
              float v[16];
#pragma unroll
              for (int u = 0; u < 16; ++u) v[u] = cv[(((size_t)b * 1024 + key + u) * 8 + h) * 128 + e];
#pragma unroll
              for (int qq = 0; qq < NQ; ++qq) {
#pragma unroll
                  for (int u4 = 0; u4 < 4; ++u4) { const f32x4 p4 = *(const LAS f32x4*)(SC + qq * SCP + key + 4 * u4); acc[qq] += (p4.x * v[4 * u4] + p4.y * v[4 * u4 + 1]) + (p4.z * v[4 * u4 + 2] + p4.w * v[4 * u4 + 3]); } } }
          { const int key = 1024 + 4 * kq; float v[4];
#pragma unroll
              for (int u = 0; u < 4; ++u) v[u] = bf2f(Vb[(srow + (key + u - 1024)) * DM + h * 128 + e]);
#pragma unroll
              for (int qq = 0; qq < NQ; ++qq) { const f32x4 p4 = *(const LAS f32x4*)(SC + qq * SCP + key); acc[qq] += (p4.x * v[0] + p4.y * v[1]) + (p4.z * v[2] + p4.w * v[3]); } }
#pragma unroll
          for (int qq = 0; qq < NQ; ++qq) OA[(kq * NQ + qq) * 128 + e] = acc[qq]; }
        __syncthreads();
        { const int qq = wid, e0 = lane * 2; float v[2];
#pragma unroll
          for (int j = 0; j < 2; ++j) v[j] = (OA[(0 * NQ + qq) * 128 + e0 + j] + OA[(1 * NQ + qq) * 128 + e0 + j]) + (OA[(2 * NQ + qq) * 128 + e0 + j] + OA[(3 * NQ + qq) * 128 + e0 + j]);
          if (c == 0) { O0[qq * 128 + e0] = v[0]; O0[qq * 128 + e0 + 1] = v[1]; }
          else { const float o0 = O0[qq * 128 + e0] - lam * v[0], o1 = O0[qq * 128 + e0 + 1] - lam * v[1];
              const float s = wave_sum(o0 * o0 + o1 * o1);
              const float r = rsqrtf(s * (1.f / 128.f) + EPS) * (1.0f - LAM_INIT);
              *(unsigned*)(OC + (srow + q0 + qq) * DM + h * 128 + e0) = pk2(o0 * r * subg[e0], o1 * r * subg[e0 + 1]); } }
        __syncthreads();
    }
}
}

#define XB_TMO      128
#define XB_XCNT(j)  (256  + 64 * (j))
#define XB_XSUB(j)  (1280 + 64 * (j))
#define XB_XGEN(j)  (2304 + 64 * (j))
#define XB_TOP      3328
#define XB_TOPGEN   3392
#define XCD_BAR_WORDS 3456
#define XB_SPIN_CAP (1u << 18)

__device__ __forceinline__ unsigned xb_ld(unsigned* p)              { return __hip_atomic_load(p, __ATOMIC_RELAXED, __HIP_MEMORY_SCOPE_AGENT); }
__device__ __forceinline__ unsigned xb_add(unsigned* p, unsigned v) { return __hip_atomic_fetch_add(p, v, __ATOMIC_RELAXED, __HIP_MEMORY_SCOPE_AGENT); }
__device__ __forceinline__ unsigned xb_xcc_id() { return (unsigned)__builtin_amdgcn_s_getreg((3 << 11) | 20) & 0xFu; }
#define XB_SPIN(cond, bar) do { unsigned _sp = 0; while (cond) { __builtin_amdgcn_s_sleep(1); \
    if ((++_sp & 255u) == 0u) { if (xb_ld(&(bar)[XB_TMO])) break; if (_sp > XB_SPIN_CAP) { atomicAdd(&(bar)[XB_TMO], 1u); break; } } } } while (0)

struct XcdBarrier {
    unsigned* bar; unsigned x;
    volatile LAS unsigned* st;
};

__device__ __forceinline__ XcdBarrier xcd_barrier_post(unsigned* bar, volatile LAS unsigned* st) {
    XcdBarrier b; b.bar = bar; b.x = xb_xcc_id(); b.st = st;
    if (threadIdx.x == 0) (void)xb_add(&bar[XB_XCNT(b.x)], 1u);
    return b;
}
__device__ __forceinline__ void xcd_barrier_complete(unsigned* bar, unsigned x, unsigned& nloc, unsigned& nx) {
    const unsigned G = gridDim.x * gridDim.y * gridDim.z;
    unsigned sum, cnt, mine, sp = 0u;
    for (;;) {
        sum = 0u; cnt = 0u; mine = 0u;
#pragma unroll
        for (unsigned j = 0; j < 16; ++j) { const unsigned c = xb_ld(&bar[XB_XCNT(j)]); sum += c; cnt += (c > 0u) ? 1u : 0u; mine = (j == x) ? c : mine; }
        if (sum == G) break;
        __builtin_amdgcn_s_sleep(1);
        if ((++sp & 255u) == 0u) { if (xb_ld(&bar[XB_TMO])) break; if (sp > XB_SPIN_CAP) { atomicAdd(&bar[XB_TMO], 1u); break; } }
    }
    nloc = mine > 0u ? mine : 1u; nx = cnt > 0u ? cnt : 1u;
}

__device__ __forceinline__ void xcd_barrier(const XcdBarrier& b) {
    asm volatile("s_waitcnt vmcnt(0)" ::: "memory");
    __syncthreads();
    if (threadIdx.x == 0) {
        unsigned* bar = b.bar;
        __builtin_amdgcn_s_waitcnt(0);
        unsigned nloc = b.st[0], nx = b.st[1];
        if (nloc == 0u) { xcd_barrier_complete(bar, b.x, nloc, nx); b.st[0] = nloc; b.st[1] = nx; }
        const unsigned old = xb_add(&bar[XB_XSUB(b.x)], 1u);
        const unsigned gen = old / nloc;
        if (old + 1u == (gen + 1u) * nloc) {
            __builtin_amdgcn_fence(__ATOMIC_RELEASE, "agent");
            asm volatile("s_waitcnt vmcnt(0)" ::: "memory");
            const unsigned og = xb_add(&bar[XB_TOP], 1u);
            const unsigned tg = og / nx;
            if (og + 1u == (tg + 1u) * nx) xb_add(&bar[XB_TOPGEN], 1u);
            else XB_SPIN(xb_ld(&bar[XB_TOPGEN]) == tg, bar);
            __builtin_amdgcn_fence(__ATOMIC_ACQUIRE, "agent");
            xb_add(&bar[XB_XGEN(b.x)], 1u);
            asm volatile("s_waitcnt vmcnt(0)" ::: "memory");
        } else {
            XB_SPIN(xb_ld(&bar[XB_XGEN(b.x)]) == gen, bar);
            __builtin_amdgcn_fence(__ATOMIC_ACQUIRE, "agent");
            asm volatile("s_waitcnt vmcnt(0)" ::: "memory");
        }
    }
    __syncthreads();
}

__global__ void __launch_bounds__(NWAVES * 64, 2) yoco_fwd(Args args) {
    extern __shared__ __attribute__((aligned(16))) unsigned char lds[];
    cg::grid_group grid = cg::this_grid();
#define GRID_SYNC() xcd_barrier(xbar)
    volatile LAS unsigned* xb_st = (volatile LAS unsigned*)((LAS unsigned char*)lds + 155136);
    if (threadIdx.x < 2) xb_st[threadIdx.x] = 0u;
    __syncthreads();
    XcdBarrier xbar = xcd_barrier_post((unsigned*)args.ws, xb_st);
    grid.sync();
    Frame F;
    F.lds = (LAS unsigned char*)lds;
#define REFRESH() do { int t_ = threadIdx.x; asm volatile("" : "+v"(t_)); F.tid = t_; F.lane = t_ & 63; F.wave = __builtin_amdgcn_readfirstlane(t_ >> 6); } while (0)
    REFRESH();
    F.G = gridDim.x; { const int bx = blockIdx.x; F.vcu = (F.G % 8 == 0) ? (bx % 8) * (F.G / 8) + bx / 8 : bx; }
    unsigned char* ws = args.ws; float* out = args.out;
    const float* x_prompt = args.in[0]; const float* x_sample = args.in[1]; const float* cache_k = args.in[2]; const float* cache_v = args.in[3]; const float* state_hgrn = args.in[4];
    const float* norm_g = args.in[5]; const float* w_hgrn_in = args.in[6]; const float* lb_logits = args.in[7]; const float* onorm_g = args.in[8]; const float* w_hgrn_out = args.in[9];
    const float* kv_norm_g = args.in[10]; const float* w_kv = args.in[11]; const float* w_dq = args.in[12]; const float* diff_lambda = args.in[13]; const float* subln_g = args.in[14];
    const float* w_do = args.in[15]; const float* w_up = args.in[16]; const float* w_down = args.in[17];
    float* OML = (float*)(ws + WS_OML);
    bf16* Wt_in = (bf16*)(ws + WS_WIN); bf16* Wt_ho = (bf16*)(ws + WS_WHO); bf16* Wt_up0 = (bf16*)(ws + WS_WUP0); bf16* Wt_dn0 = (bf16*)(ws + WS_WDN0);
    bf16* Wt_qkv = (bf16*)(ws + WS_WQKV); bf16* Wt_do = (bf16*)(ws + WS_WDO); bf16* Wt_up1 = (bf16*)(ws + WS_WUP1); bf16* Wt_dn1 = (bf16*)(ws + WS_WDN1);
    bf16* XN = (bf16*)(ws + WS_XN); bf16* MB = (bf16*)(ws + WS_MB); bf16* R0 = (bf16*)(ws + WS_R0);
    bf16* QB = (bf16*)(ws + WS_Q); bf16* KB = (bf16*)(ws + WS_K); bf16* VB = (bf16*)(ws + WS_V); bf16* O1 = (bf16*)(ws + WS_O1); bf16* O2 = (bf16*)(ws + WS_O2); bf16* OC = QB; float* RS = (float*)(ws + WS_RS); float* PACC = (float*)(ws + WS_PACC);
    const int NGW = F.G * NWAVES;

    {
        const int gw = F.vcu * NWAVES + F.wave;
        LAS float* scr = (LAS float*)(F.lds + RING_OFF + F.wave * 16384);
        constexpr int I_SQ = (DM / 64) * (DM / 32), I_UP = (DM / 64) * (FF / 32), I_DN = (FF / 64) * (DM / 32), I_KV = (DM / 64) * (2 * DM / 32);
        constexpr int NITEMS = I_UP   + I_SQ   + 2 * I_UP + 2 * I_DN + I_SQ   + I_KV + I_SQ  ;
#define W_ITEM(it_) do { int r = (it_); \
            if (r < I_UP) { p0_transpose_item(w_hgrn_in, norm_g + 0 * DM, DM, FF, Wt_in, 0, scr, r, F.lane); break; } r -= I_UP; \
            if (r < I_SQ) { p0_transpose_item(w_hgrn_out, nullptr, DM, DM, Wt_ho, 0, scr, r, F.lane); break; } r -= I_SQ; \
            if (r < I_UP) { p0_transpose_item(w_up, norm_g + 2 * DM, DM, FF, Wt_up0, 0, scr, r, F.lane); break; } r -= I_UP; \
            if (r < I_UP) { p0_transpose_item(w_up + (size_t)DM * FF, norm_g + 6 * DM, DM, FF, Wt_up1, 0, scr, r, F.lane); break; } r -= I_UP; \
            if (r < I_DN) { p0_transpose_item(w_down, nullptr, FF, DM, Wt_dn0, 0, scr, r, F.lane); break; } r -= I_DN; \
            if (r < I_DN) { p0_transpose_item(w_down + (size_t)FF * DM, nullptr, FF, DM, Wt_dn1, 0, scr, r, F.lane); break; } r -= I_DN; \
            if (r < I_SQ) { p0_transpose_item(w_dq, norm_g + 4 * DM, DM, DM, Wt_qkv, 0, scr, r, F.lane); break; } r -= I_SQ; \
            if (r < I_KV) { p0_transpose_item(w_kv, kv_norm_g, DM, 2 * DM, Wt_qkv, DM, scr, r, F.lane); break; } r -= I_KV; \
            p0_transpose_item(w_do, nullptr, DM, DM, Wt_do, 0, scr, r, F.lane); } while (0)
        for (int it = gw; it < ((F.G > 192) ? I_UP : NITEMS); it += NGW) W_ITEM(it);
        if (blockIdx.x == 0) { for (int c = F.tid; c < DM; c += NWAVES * 64) { const float l0 = lb_logits[c], l1 = lb_logits[DM + c]; OML[c] = 1.0f / (1.0f + __expf(l0 - l1)); } }
        for (int m = gw; m < M; m += NGW) rms_row_to_bf16(m < NP ? x_prompt + (size_t)m * DM : x_sample + (size_t)(m - NP) * DM, XN + (size_t)m * DM, RS + m, F.lane);
    }
    GRID_SYNC(); if (STOP_AFTER == 0) return;

    {
        pg8::Gemm g{XN, Wt_in, M, FF, DM}; pg8::StaticOrder S; S.init(M, FF, F.G, (int)blockIdx.x);
        pg8::EpiAct<2> E{R0, FF, OML, nullptr, nullptr, 0, 1.f};
        pg8::gemm_phase<pg8::EpiAct<2>, pg8::StaticOrder, PG8_ALIGN, PG8_SP2>(F.lds + RING_OFF, g, S, E);
    }
    GRID_SYNC(); if (STOP_AFTER == 1) { REFRESH(); for (int row = F.vcu * NWAVES + F.wave; row < NP; row += NGW) for (int c = F.lane; c < DM; c += 64) { out[(size_t)row * DM + c] = bf2f(R0[(size_t)row * FF + c]); out[O_KP + (size_t)row * DM + c] = bf2f(R0[(size_t)row * FF + 3072 + c]); } return; }

    if ((int)blockIdx.x >= 192) {
        REFRESH();
        LAS float* scr = (LAS float*)(F.lds + RING_OFF + F.wave * 16384);
        constexpr int I_SQ = (DM / 64) * (DM / 32), I_UP = (DM / 64) * (FF / 32), I_DN = (FF / 64) * (DM / 32), I_KV = (DM / 64) * (2 * DM / 32);
        constexpr int NITEMS = I_UP + I_SQ + 2 * I_UP + 2 * I_DN + I_SQ + I_KV + I_SQ;
        const int nidle = ((int)F.G - 192) * NWAVES;
        for (int it = I_UP + ((int)blockIdx.x - 192) * NWAVES + F.wave; it < NITEMS; it += nidle) W_ITEM(it);
    }
    for (int it = blockIdx.x; it < 64 + 128; it += F.G) {
        if (it < 64) { const int b = it >> 3, h = it & 7;
            hg::hgrn_item<64>(F.lds + RING_OFF, R0, O2, nullptr, out + O_STP + (size_t)it * 16384, (long)b * 8192, 128, h, onorm_g); }
        else { const int is = it - 64, b = is >> 3, h = is & 7;
            hg::hgrn_item<16>(F.lds + RING_OFF, R0, O2, state_hgrn + (size_t)is * 16384, out + O_STS + (size_t)is * 16384, (long)NP + b * 16, 1, h, onorm_g); }
    }
    GRID_SYNC(); if (STOP_AFTER == 2) { REFRESH(); for (int row = F.vcu * NWAVES + F.wave; row < M; row += NGW) for (int c = F.lane; c < DM; c += 64) out[(size_t)row * DM + c] = bf2f(XN[(size_t)row * DM + c]) - bf2f(MB[(size_t)row * DM + c]);
        for (size_t i = (size_t)blockIdx.x * 512 + F.tid; i < (size_t)192 * 16384; i += (size_t)F.G * 512) { const float a = (i < (size_t)64 * 16384) ? out[O_STP + i] : out[O_STS + i - (size_t)64 * 16384]; out[(size_t)1024 * DM + i] = a - ((const float*)(ws + 900 * MiB))[i]; }
        return; }

    {
        pg8::Gemm g{O2, Wt_ho, M, DM, DM}; pg8::StaticOrder S; S.init(M, DM, F.G, (int)blockIdx.x, DM, SPLK);
        pg8::EpiAct<0> E{MB, DM, nullptr, nullptr, nullptr, 0, 1.f, PACC};
        pg8::gemm_phase<pg8::EpiAct<0>, pg8::StaticOrder, PG8_ALIGN, PG8_SP2>(F.lds + RING_OFF, g, S, E);
    }
    GRID_SYNC(); if (STOP_AFTER == 3) { REFRESH(); for (int row = F.vcu * NWAVES + F.wave; row < M; row += NGW) for (int c = F.lane; c < DM; c += 64) out[(size_t)row * DM + c] = bf2f(MB[(size_t)row * DM + c]); return; }
    REFRESH(); norm_phase<false>(F, MB, PACC, norm_g + 1 * DM, RS, out, XN);
    GRID_SYNC(); if (STOP_AFTER == 4) return;
    {
        pg8::Gemm g{XN, Wt_up0, M, FF, DM}; pg8::StaticOrder S; S.init(M, FF, F.G, (int)blockIdx.x);
        pg8::EpiAct<1> E{R0, FF, nullptr, nullptr, nullptr, 0, 1.f};
        pg8::gemm_phase<pg8::EpiAct<1>, pg8::StaticOrder, PG8_ALIGN, PG8_SP2>(F.lds + RING_OFF, g, S, E);
    }
    GRID_SYNC(); if (STOP_AFTER == 5) return;
    {
        pg8::Gemm g{R0, Wt_dn0, M, DM, FF}; pg8::StaticOrder S; S.init(M, DM, F.G, (int)blockIdx.x, FF, SPLK);
        pg8::EpiAct<0> E{MB, DM, nullptr, nullptr, nullptr, 0, 1.f, PACC};
        pg8::gemm_phase<pg8::EpiAct<0>, pg8::StaticOrder, PG8_ALIGN, PG8_SP2>(F.lds + RING_OFF, g, S, E);
    }
    GRID_SYNC(); if (STOP_AFTER == 6) return;
    REFRESH(); norm_phase<false>(F, MB, PACC, norm_g + 3 * DM, RS, out, XN);
    GRID_SYNC(); if (STOP_AFTER == 7) return;
    {
        pg8::Gemm g{XN, Wt_qkv, M, 3 * DM, DM}; pg8::StaticOrder S; S.init(M, 3 * DM, F.G, (int)blockIdx.x);
        pg8::EpiAct<3> E{QB, DM, nullptr, out + O_KP, out + O_KS, (size_t)(WS_K - WS_Q) / 2, attn_body::C2};
        pg8::gemm_phase<pg8::EpiAct<3>, pg8::StaticOrder, PG8_ALIGN, PG8_SP2>(F.lds + RING_OFF, g, S, E);
    }
    GRID_SYNC(); if (STOP_AFTER == 8) return;
    {
        const attn_body::AttnTensors AT{(const attn_body::bf16*)QB, (const attn_body::bf16*)KB, (const attn_body::bf16*)VB, (attn_body::bf16*)O1, (attn_body::bf16*)O2};
        const attn_body::StaticOrder S((int)F.G, (int)blockIdx.x);
        attn_body::attn_phase<attn_body::StaticOrder>((char*)lds + RING_OFF, AT, S);
        asm volatile("s_waitcnt vmcnt(0) lgkmcnt(0)" ::: "memory"); __syncthreads();
        REFRESH(); const float lam = compute_lam(diff_lambda, F.lane);
        for (int it = F.vcu; it < 256; it += F.G) sa::item(F.lds + RING_OFF, it, QB, KB, VB, cache_k, cache_v, OC, lam, subln_g);
    }
    GRID_SYNC(); if (STOP_AFTER == 9) return;
    REFRESH(); combine_phase(F, O1, O2, diff_lambda, subln_g, OC);
    GRID_SYNC(); if (STOP_AFTER == 10) return;
    {
        pg8::Gemm g{OC, Wt_do, M, DM, DM}; pg8::StaticOrder S; S.init(M, DM, F.G, (int)blockIdx.x, DM, SPLK);
        pg8::EpiAct<0> E{MB, DM, nullptr, nullptr, nullptr, 0, 1.f, PACC};
        pg8::gemm_phase<pg8::EpiAct<0>, pg8::StaticOrder, PG8_ALIGN, PG8_SP2>(F.lds + RING_OFF, g, S, E);
    }
    GRID_SYNC(); if (STOP_AFTER == 11) return;
    REFRESH(); norm_phase<false>(F, MB, PACC, norm_g + 5 * DM, RS, out, XN);
    GRID_SYNC(); if (STOP_AFTER == 12) return;
    {
        pg8::Gemm g{XN, Wt_up1, M, FF, DM}; pg8::StaticOrder S; S.init(M, FF, F.G, (int)blockIdx.x);
        pg8::EpiAct<1> E{R0, FF, nullptr, nullptr, nullptr, 0, 1.f};
        pg8::gemm_phase<pg8::EpiAct<1>, pg8::StaticOrder, PG8_ALIGN, PG8_SP2>(F.lds + RING_OFF, g, S, E);
    }
    GRID_SYNC(); if (STOP_AFTER == 13) return;
    {
        pg8::Gemm g{R0, Wt_dn1, M, DM, FF}; pg8::StaticOrder S; S.init(M, DM, F.G, (int)blockIdx.x, FF, SPLK);
        pg8::EpiAct<0> E{MB, DM, nullptr, nullptr, nullptr, 0, 1.f, PACC};
        pg8::gemm_phase<pg8::EpiAct<0>, pg8::StaticOrder, PG8_ALIGN, PG8_SP2>(F.lds + RING_OFF, g, S, E);
    }
    GRID_SYNC(); if (STOP_AFTER == 14) return;
    REFRESH(); norm_phase<true>(F, MB, PACC, norm_g + 7 * DM, RS, out, XN);
}

extern "C" void kernel_launch(void* const* d_in, const int* in_sizes, int n_in, void* d_out, int out_size, void* d_ws, size_t ws_size, hipStream_t stream) {
    static int grid = 0;
    if (grid == 0) {
        if (n_in != 18 || in_sizes[0] != NP * DM || (size_t)out_size != O_END || ws_size < WS_END) {
            fprintf(stderr, "kernel_launch: shape mismatch: n_in %d in0 %d out %d ws %zu (need out %zu ws %zu); nothing launched\n", n_in, n_in > 0 ? in_sizes[0] : -1, out_size, ws_size, (size_t)O_END, (size_t)WS_END); grid = -1; return; }
        int dev = 0, cus = 0, per_cu = 0;
        if (hipGetDevice(&dev) != hipSuccess || hipDeviceGetAttribute(&cus, hipDeviceAttributeMultiprocessorCount, dev) != hipSuccess) { fprintf(stderr, "kernel_launch: device query failed\n"); grid = -1; return; }
        if (hipFuncSetAttribute((const void*)yoco_fwd, hipFuncAttributeMaxDynamicSharedMemorySize, LDS_BYTES) != hipSuccess) { fprintf(stderr, "kernel_launch: hipFuncSetAttribute failed\n"); grid = -1; return; }
        if (hipOccupancyMaxActiveBlocksPerMultiprocessor(&per_cu, (const void*)yoco_fwd, NWAVES * 64, LDS_BYTES) != hipSuccess || per_cu < 1) { fprintf(stderr, "kernel_launch: occupancy query says %d\n", per_cu); per_cu = 1; }
        (void)hipGetLastError();
        grid = cus;
    }
    if (grid < 0) return;
    if (hipMemsetAsync(d_ws, 0, 16384, stream) != hipSuccess) { fprintf(stderr, "kernel_launch: memset failed\n"); return; }
    Args a{};
    for (int i = 0; i < 18; ++i) a.in[i] = (const float*)d_in[i];
    a.out = (float*)d_out; a.ws = (unsigned char*)d_ws;
    void* kargs[] = {&a};
    hipError_t e = hipLaunchCooperativeKernel((const void*)yoco_fwd, dim3(grid), dim3(NWAVES * 64), kargs, LDS_BYTES, stream);
    if (e != hipSuccess) fprintf(stderr, "kernel_launch: cooperative launch failed: %s (grid %d)\n", hipGetErrorString(e), grid);
}
```
